# Optimizing an MI355X kernel written in HIP

```python
import jax, jax.numpy as jnp
from jax import lax
import numpy as np


D_MODEL = 1024
BATCH = 8
SEQ = 2048
DEPTH = 2

GRID_W = 64
CTX_LEN = 256
N_MIXERS = 2
EPS = 1e-6

CHUNK = 128
A_GROUPS = 8
A_WIDTH = 2 * D_MODEL
A_GW = A_WIDTH // A_GROUPS

HEAD_DIM = 64
B_Q_HEADS = D_MODEL // HEAD_DIM
B_KV_HEADS = 4
B_GROUP = B_Q_HEADS // B_KV_HEADS
Q_DIM = B_Q_HEADS * HEAD_DIM
KV_DIM = B_KV_HEADS * HEAD_DIM
WINDOW = 128
BLOCK = 128
ROPE_BASE = 10000.0
ROPE_PAIRS_AXIS = HEAD_DIM // 4

N_EXPERTS = 16
N_EXPERT_GROUPS = 4
EXPERTS_PER_GROUP = N_EXPERTS // N_EXPERT_GROUPS
TOP_K = 2
D_EXPERT = D_MODEL // 2

kernel_name = 'hybrid_dit_gmlp_swa_moe'


def rmsnorm(x, g):
    xf = x.astype(jnp.float32)
    y = xf * lax.rsqrt(jnp.mean(xf * xf, axis=-1, keepdims=True) + EPS)
    return (y * g.astype(jnp.float32)).astype(x.dtype)


def modulate(h, shift, scale):
    return h * (1 + scale) + shift


def adaln(cvec, w, b):
    m = jax.nn.silu(cvec) @ w + b
    return jnp.split(m[..., None, :], 6, axis=-1)


def chunk_gmlp(h, w_in, g_v, w_s, b_s, w_out):
    bsz, n, _ = h.shape
    uv = jax.nn.gelu(h @ w_in)
    u, v = jnp.split(uv, 2, axis=-1)
    v = rmsnorm(v, g_v).reshape(bsz, n // CHUNK, CHUNK, A_GROUPS, A_GW)
    v = jnp.einsum('gpq,bcqgd->bcpgd', w_s, v) + b_s.T[None, None, :, :, None]
    return (u * v.reshape(bsz, n, A_WIDTH)) @ w_out


def axial_angles(n):
    rows = n // GRID_W
    row = jnp.repeat(jnp.arange(rows, dtype=jnp.float32), GRID_W)
    col = jnp.tile(jnp.arange(GRID_W, dtype=jnp.float32), rows)
    inv = ROPE_BASE ** (-jnp.arange(ROPE_PAIRS_AXIS, dtype=jnp.float32) / ROPE_PAIRS_AXIS)
    return jnp.stack([row[:, None] * inv, col[:, None] * inv], axis=1)


def apply_rope(x, ang):
    b, n, hh, d = x.shape
    xa = x.reshape(b, n, hh, 2, 2, ROPE_PAIRS_AXIS)
    cos = jnp.cos(ang)[None, :, None].astype(x.dtype)
    sin = jnp.sin(ang)[None, :, None].astype(x.dtype)
    x1, x2 = xa[..., 0, :], xa[..., 1, :]
    out = jnp.stack([x1 * cos - x2 * sin, x2 * cos + x1 * sin], axis=-2)
    return out.reshape(b, n, hh, d)


def qkv_split(qkv):
    b, n, _ = qkv.shape
    q, k, v = jnp.split(qkv, [Q_DIM, Q_DIM + KV_DIM], axis=-1)
    return (q.reshape(b, n, B_Q_HEADS, HEAD_DIM),
            k.reshape(b, n, B_KV_HEADS, HEAD_DIM),
            v.reshape(b, n, B_KV_HEADS, HEAD_DIM))


def window_gqa(h, hc, w_qkv, sink, w_o, need_ctx):
    bsz, n, _ = h.shape
    nb = n // BLOCK
    scale = HEAD_DIM ** -0.5
    q, k, v = qkv_split(h @ w_qkv)
    qc, kc, vc = qkv_split(hc @ w_qkv)
    ang = axial_angles(n)
    q = apply_rope(q, ang)
    k = apply_rope(k, ang)
    kc32 = kc.astype(jnp.float32)
    sink32 = sink.astype(jnp.float32).reshape(B_KV_HEADS, B_GROUP)
    pad = ((0, 0), (BLOCK, BLOCK), (0, 0), (0, 0))
    k_pad = jnp.pad(k, pad)
    v_pad = jnp.pad(v, pad)
    qb = (q.astype(jnp.float32) * scale).reshape(bsz, nb, BLOCK, B_KV_HEADS, B_GROUP, HEAD_DIM)
    qb = jnp.moveaxis(qb, 1, 0)

    def block(args):
        qi, start = args
        kw = lax.dynamic_slice_in_dim(k_pad, start, 3 * BLOCK, axis=1)
        vw = lax.dynamic_slice_in_dim(v_pad, start, 3 * BLOCK, axis=1)
        qpos = start + jnp.arange(BLOCK)
        kpos = start - BLOCK + jnp.arange(3 * BLOCK)
        valid = ((jnp.abs(kpos[None, :] - qpos[:, None]) <= WINDOW)
                 & (kpos >= 0)[None, :] & (kpos < n)[None, :])
        s_win = jnp.einsum('bqhgd,bkhd->bhgqk', qi, kw.astype(jnp.float32))
        s_win = jnp.where(valid[None, None, None], s_win, -jnp.inf)
        s_ctx = jnp.einsum('bqhgd,bkhd->bhgqk', qi, kc32)
        s_sink = jnp.broadcast_to(sink32[None, :, :, None, None], s_ctx.shape[:-1] + (1,))
        p = jax.nn.softmax(jnp.concatenate([s_sink, s_ctx, s_win], axis=-1), axis=-1)
        p = p.astype(v.dtype)
        n_ctx = kc.shape[1]
        return (jnp.einsum('bhgqk,bkhd->bqhgd', p[..., 1:1 + n_ctx], vc)
                + jnp.einsum('bhgqk,bkhd->bqhgd', p[..., 1 + n_ctx:], vw))

    o = lax.map(block, (qb, jnp.arange(nb) * BLOCK))
    y = jnp.moveaxis(o, 0, 1).reshape(bsz, n, Q_DIM) @ w_o
    if not need_ctx:
        return y, None
    n_ctx = hc.shape[1]
    qc32 = (qc.astype(jnp.float32) * scale).reshape(bsz, n_ctx, B_KV_HEADS, B_GROUP, HEAD_DIM)
    sc = jnp.einsum('bqhgd,bkhd->bhgqk', qc32, kc32)
    sc_sink = jnp.broadcast_to(sink32[None, :, :, None, None], sc.shape[:-1] + (1,))
    pc = jax.nn.softmax(jnp.concatenate([sc_sink, sc], axis=-1), axis=-1)[..., 1:].astype(vc.dtype)
    oc = jnp.einsum('bhgqk,bkhd->bqhgd', pc, vc).reshape(bsz, n_ctx, Q_DIM)
    return y, oc @ w_o


def moe(h, w_router, b_router, w_gate, w_up, w_down):
    s = jax.nn.sigmoid((h @ w_router).astype(jnp.float32))
    sb = s + b_router.astype(jnp.float32)
    grp = sb.reshape(sb.shape[:-1] + (N_EXPERT_GROUPS, EXPERTS_PER_GROUP))
    grp_score = jnp.sum(lax.top_k(grp, TOP_K)[0], axis=-1)
    best = jnp.argmax(grp_score, axis=-1)
    in_group = (jnp.arange(N_EXPERTS) // EXPERTS_PER_GROUP) == best[..., None]
    _, idx = lax.top_k(jnp.where(in_group, sb, -jnp.inf), TOP_K)
    w = jnp.take_along_axis(s, idx, axis=-1)
    w = w / jnp.sum(w, axis=-1, keepdims=True)
    gates = jnp.sum(jax.nn.one_hot(idx, N_EXPERTS, dtype=jnp.float32) * w[..., None], axis=-2)
    gates = gates.astype(h.dtype)
    out = jnp.zeros_like(h)
    for e in range(N_EXPERTS):
        y = (jax.nn.silu(h @ w_gate[e]) * (h @ w_up[e])) @ w_down[e]
        out = out + gates[..., e:e + 1] * y
    return out


def setup_inputs(seed: int = 0) -> dict:
    key = jax.random.key(seed)
    ks = jax.random.split(key, 24)
    n_a = (DEPTH + N_MIXERS - 1) // N_MIXERS
    n_b = DEPTH // N_MIXERS
    nrm = jax.random.normal
    f32 = jnp.float32
    d = D_MODEL
    return {
        'x': nrm(ks[0], (BATCH, SEQ, d), f32),
        'c': nrm(ks[1], (BATCH, d), f32),
        'ctx': nrm(ks[2], (BATCH, CTX_LEN, d), f32),
        'c_ctx': nrm(ks[3], (d,), f32),
        'ada_w': nrm(ks[4], (DEPTH, d, 6 * d), f32) * (0.3 * d ** -0.5),
        'ada_b': nrm(ks[5], (DEPTH, 6 * d), f32) * 0.02,
        'norm1_g': 1.0 + 0.02 * nrm(ks[6], (DEPTH, d), f32),
        'norm2_g': 1.0 + 0.02 * nrm(ks[7], (DEPTH, d), f32),
        'a_w_in': nrm(ks[8], (n_a, d, 2 * A_WIDTH), f32) * d ** -0.5,
        'a_g_v': 1.0 + 0.02 * nrm(ks[9], (n_a, A_WIDTH), f32),
        'a_w_s': nrm(ks[10], (n_a, A_GROUPS, CHUNK, CHUNK), f32) * CHUNK ** -0.5,
        'a_b_s': nrm(ks[11], (n_a, A_GROUPS, CHUNK), f32) * 0.02,
        'a_w_out': nrm(ks[12], (n_a, A_WIDTH, d), f32) * A_WIDTH ** -0.5,
        'b_w_qkv': nrm(ks[13], (n_b, d, Q_DIM + 2 * KV_DIM), f32) * d ** -0.5,
        'b_sink': nrm(ks[14], (n_b, B_Q_HEADS), f32),
        'b_w_o': nrm(ks[15], (n_b, Q_DIM, d), f32) * Q_DIM ** -0.5,
        'router_w': nrm(ks[16], (d, N_EXPERTS), f32) * d ** -0.5,
        'router_b': nrm(ks[17], (N_EXPERTS,), f32) * 0.01,
        'moe_w_gate': nrm(ks[18], (DEPTH, N_EXPERTS, d, D_EXPERT), f32) * d ** -0.5,
        'moe_w_up': nrm(ks[19], (DEPTH, N_EXPERTS, d, D_EXPERT), f32) * d ** -0.5,
        'moe_w_down': nrm(ks[20], (DEPTH, N_EXPERTS, D_EXPERT, d), f32) * D_EXPERT ** -0.5,
        'final_g': 1.0 + 0.02 * nrm(ks[21], (d,), f32),
    }


def reference(x, c, ctx, c_ctx, ada_w, ada_b, norm1_g, norm2_g, a_w_in, a_g_v, a_w_s, a_b_s, a_w_out,
              b_w_qkv, b_sink, b_w_o, router_w, router_b, moe_w_gate, moe_w_up, moe_w_down, final_g):
    cx = ctx
    n_ctx = ctx.shape[1]
    for i in range(DEPTH):
        last = i == DEPTH - 1
        sh1, sc1, g1, sh2, sc2, g2 = adaln(c, ada_w[i], ada_b[i])
        csh1, csc1, cg1, csh2, csc2, cg2 = adaln(c_ctx, ada_w[i], ada_b[i])
        h = modulate(rmsnorm(x, norm1_g[i]), sh1, sc1)
        hc = modulate(rmsnorm(cx, norm1_g[i]), csh1, csc1)
        j = i // N_MIXERS
        if i % N_MIXERS == 0:
            y = chunk_gmlp(h, a_w_in[j], a_g_v[j], a_w_s[j], a_b_s[j], a_w_out[j])
            yc = None if last else chunk_gmlp(hc, a_w_in[j], a_g_v[j], a_w_s[j], a_b_s[j], a_w_out[j])
        else:
            y, yc = window_gqa(h, hc, b_w_qkv[j], b_sink[j], b_w_o[j], not last)
        x = x + g1 * y
        h2 = modulate(rmsnorm(x, norm2_g[i]), sh2, sc2)
        if last:
            x = x + g2 * moe(h2, router_w, router_b, moe_w_gate[i], moe_w_up[i], moe_w_down[i])
        else:
            cx = cx + cg1 * yc
            hc2 = modulate(rmsnorm(cx, norm2_g[i]), csh2, csc2)
            out = moe(jnp.concatenate([hc2, h2], axis=1), router_w, router_b,
                      moe_w_gate[i], moe_w_up[i], moe_w_down[i])
            cx = cx + cg2 * out[:, :n_ctx]
            x = x + g2 * out[:, n_ctx:]
    return rmsnorm(x, final_g)
```

```cpp
#include <hip/hip_runtime.h>
#include <cstdint>
#include <cstdio>

#define LAS __attribute__((address_space(3)))
typedef unsigned short bf16_t;
typedef short bf16x8 __attribute__((ext_vector_type(8)));
typedef float f32x4 __attribute__((ext_vector_type(4)));
typedef float f32x2 __attribute__((ext_vector_type(2)));
typedef unsigned u32x4 __attribute__((ext_vector_type(4)));
typedef unsigned u32x2 __attribute__((ext_vector_type(2)));

#ifndef MK_N_LAUNCHES
#define MK_N_LAUNCHES 0
#endif

constexpr int D = 1024, NBATCH = 8, SEQ = 2048, NX = NBATCH * SEQ, CTXL = 256, NCX = NBATCH * CTXL, NT = NX + NCX;
constexpr int AW = 2048, CHUNK = 128, NGRP = 8, GW = 256;
constexpr int NE = 16, DE = 512;
constexpr int NQKV = 1536, KVD = 256, HD = 64;
constexpr float EPS = 1e-6f;
constexpr float LOG2E = 1.4426950408889634f;
constexpr float QSCALE = 0.125f * LOG2E;
constexpr int NTHREADS = 512, NWAVES = 8;
constexpr int LDS_BYTES = 147456;
constexpr int MISC_OFF = 131072 + 320;
constexpr int LDSCTL_OFF = 131072;

constexpr size_t MiB = 1u << 20;
constexpr size_t WS_CTL = 0, CTL_ZERO_BYTES = 1 * MiB;
constexpr size_t WS_MODP = 1 * MiB;
constexpr size_t WS_MODF = 3 * MiB;
constexpr size_t WS_TOKE = 4 * MiB;
constexpr size_t WS_TOKP = 4 * MiB + 256 * 1024;
constexpr size_t WS_TOKW = 4 * MiB + 512 * 1024;
constexpr size_t WS_LIST = 5 * MiB;
constexpr size_t WS_VSQ = 7 * MiB;
constexpr size_t WS_WSBF = 10 * MiB;
constexpr size_t WS_WIN = 11 * MiB;
constexpr size_t WS_WOUT = 19 * MiB;
constexpr size_t WS_WQKV = 23 * MiB;
constexpr size_t WS_WO = 26 * MiB;
constexpr size_t WS_GU = 28 * MiB;
constexpr size_t WS_DN = 92 * MiB;
constexpr size_t WS_H = 124 * MiB;
constexpr size_t WS_CX = 160 * MiB;
constexpr size_t WS_OV = 168 * MiB;
constexpr size_t WS_U = WS_OV;
constexpr size_t WS_VT = WS_OV + 72 * MiB;
constexpr size_t WS_HID = WS_OV;
constexpr size_t WS_Y = WS_OV + 40 * MiB;
constexpr size_t WS_Q = WS_OV;
constexpr size_t WS_K = WS_OV + 32 * MiB;
constexpr size_t WS_V = WS_OV + 41 * MiB;
constexpr size_t WS_O = WS_OV + 50 * MiB;
constexpr size_t WS_END = WS_OV + 144 * MiB;
constexpr int CW_CNT = 64;
constexpr int CW_BAR = 4096;

__device__ __forceinline__ float bf2f(bf16_t v) { return __uint_as_float((unsigned)v << 16); }
__device__ __forceinline__ unsigned f2bf(float f) { unsigned u = __float_as_uint(f); return (u + 0x7fffu + ((u >> 16) & 1u)) >> 16; }
__device__ __forceinline__ unsigned pk2(float lo, float hi) { return f2bf(lo) | (f2bf(hi) << 16); }
__device__ __forceinline__ float wave_sum(float v) {
#pragma unroll
    for (int o = 1; o < 64; o <<= 1) v += __shfl_xor(v, o);
    return v;
}
__device__ __forceinline__ float gelu_tanh(float x) { const float z = 0.7978845608028654f * (x + 0.044715f * x * x * x); return x / (1.f + __expf(-2.f * z)); }
__device__ __forceinline__ float silu_f(float x) { return x / (1.f + __expf(-x)); }
__device__ __forceinline__ float sigmoid_f(float x) { return 1.f / (1.f + __expf(-x)); }

#define XB_TMO      128
#define XB_XCNT(j)  (256  + 64 * (j))
#define XB_XSUB(j)  (1280 + 64 * (j))
#define XB_XGEN(j)  (2304 + 64 * (j))
#define XB_TOP      3328
#define XB_TOPGEN   3392
#define XCD_BAR_WORDS 3456
#define XB_SPIN_CAP (1u << 22)
__device__ __forceinline__ unsigned xb_ld(unsigned* p)              { return __hip_atomic_load(p, __ATOMIC_RELAXED, __HIP_MEMORY_SCOPE_AGENT); }
__device__ __forceinline__ unsigned xb_add(unsigned* p, unsigned v) { return __hip_atomic_fetch_add(p, v, __ATOMIC_RELAXED, __HIP_MEMORY_SCOPE_AGENT); }
__device__ __forceinline__ unsigned xb_xcc_id() { return (unsigned)__builtin_amdgcn_s_getreg((3 << 11) | 20) & 0xFu; }
#define XB_SPIN(cond, bar) do { unsigned _sp = 0; while (cond) { __builtin_amdgcn_s_sleep(1); \
    if ((++_sp & 255u) == 0u) { if (xb_ld(&(bar)[XB_TMO])) break; if (_sp > XB_SPIN_CAP) { atomicAdd(&(bar)[XB_TMO], 1u); break; } } } } while (0)
struct XcdBarrier { unsigned* bar; unsigned x; volatile LAS unsigned* st; };
__device__ __forceinline__ XcdBarrier xcd_barrier_post(unsigned* bar, volatile LAS unsigned* st) {
    XcdBarrier b; b.bar = bar; b.x = xb_xcc_id(); b.st = st;
    if (threadIdx.x == 0) (void)xb_add(&bar[XB_XCNT(b.x)], 1u);
    return b;
}
__device__ __forceinline__ void xcd_barrier_complete(unsigned* bar, unsigned x, unsigned& nloc, unsigned& nx) {
    const unsigned G = gridDim.x * gridDim.y * gridDim.z;
    unsigned sum, cnt, mine, sp = 0u;
    for (;;) {
        sum = 0u; cnt = 0u; mine = 0u;
#pragma unroll
        for (unsigned j = 0; j < 16; ++j) { const unsigned c = xb_ld(&bar[XB_XCNT(j)]); sum += c; cnt += (c > 0u) ? 1u : 0u; mine = (j == x) ? c : mine; }
        if (sum == G) break;
        __builtin_amdgcn_s_sleep(1);
        if ((++sp & 255u) == 0u) { if (xb_ld(&bar[XB_TMO])) break; if (sp > XB_SPIN_CAP) { atomicAdd(&bar[XB_TMO], 1u); break; } }
    }
    nloc = mine > 0u ? mine : 1u; nx = cnt > 0u ? cnt : 1u;
}
__device__ __forceinline__ void xcd_barrier(const XcdBarrier& b) {
    asm volatile("s_waitcnt vmcnt(0)" ::: "memory");
    __syncthreads();
    if (threadIdx.x == 0) {
        unsigned* bar = b.bar;
        __builtin_amdgcn_s_waitcnt(0);
        unsigned nloc = b.st[0], nx = b.st[1];
        if (nloc == 0u) { xcd_barrier_complete(bar, b.x, nloc, nx); b.st[0] = nloc; b.st[1] = nx; }
        const unsigned old = xb_add(&bar[XB_XSUB(b.x)], 1u);
        const unsigned gen = old / nloc;
        if (old + 1u == (gen + 1u) * nloc) {
            __builtin_amdgcn_fence(__ATOMIC_RELEASE, "agent");
            asm volatile("s_waitcnt vmcnt(0)" ::: "memory");
            const unsigned og = xb_add(&bar[XB_TOP], 1u);
            const unsigned tg = og / nx;
            if (og + 1u == (tg + 1u) * nx) xb_add(&bar[XB_TOPGEN], 1u);
            else XB_SPIN(xb_ld(&bar[XB_TOPGEN]) == tg, bar);
            __builtin_amdgcn_fence(__ATOMIC_ACQUIRE, "agent");
            xb_add(&bar[XB_XGEN(b.x)], 1u);
            asm volatile("s_waitcnt vmcnt(0)" ::: "memory");
        } else {
            XB_SPIN(xb_ld(&bar[XB_XGEN(b.x)]) == gen, bar);
            __builtin_amdgcn_fence(__ATOMIC_ACQUIRE, "agent");
            asm volatile("s_waitcnt vmcnt(0)" ::: "memory");
        }
    }
    __syncthreads();
}

struct Params { const float* in[22]; float* out; unsigned char* ws; int ph_lo, ph_hi; };
enum { I_X = 0, I_C, I_CTX, I_CCTX, I_ADAW, I_ADAB, I_N1G, I_N2G, I_AWIN, I_AGV, I_AWS, I_ABS, I_AWOUT, I_BQKV, I_BSINK, I_BWO, I_RW, I_RB, I_MG, I_MU, I_MD, I_FG };

struct Frame {
    const float* in[22]; float* out; unsigned char* ws;
    LAS unsigned char* lds;
    int tid, lane, wave, G;
    unsigned* ctl; float* modp; float* modf; int* toke; int* tokp; float* tokw; int* list; float* vsq;
    bf16_t *wsbf, *win, *wout, *wqkv, *wo, *gu, *dn, *h, *u, *vt, *hid, *y, *q, *k, *v, *o; float* cx;
};
__device__ __forceinline__ float* xb_row(const Frame& F, int row) { return row < NX ? F.out + (size_t)row * D : F.cx + (size_t)(row - NX) * D; }
__device__ __forceinline__ const float* xin_row(const Frame& F, int row) { return row < NX ? F.in[I_X] + (size_t)row * D : F.in[I_CTX] + (size_t)(row - NX) * D; }
__device__ __forceinline__ float mod_from_partials(const Frame& F, int l, int r, int n) {
    float s = F.in[I_ADAB][l * 6144 + n];
#pragma unroll
    for (int kc = 0; kc < 4; ++kc) s += F.modp[(size_t)((kc * 2 + l) * 9 + r) * 6144 + n];
    return s;
}

__device__ __forceinline__ void transpose_item(const float* W, int ldw, int k0, int n0, bf16_t* WT, int ldo, int out_row0, LAS float* scr, int lane) {
#pragma unroll 8
    for (int i = 0; i < 32; ++i) { const int kk = 2 * i + (lane >> 5); scr[kk * 33 + (lane & 31)] = W[(size_t)(k0 + kk) * ldw + n0 + (lane & 31)]; }
    asm volatile("s_waitcnt lgkmcnt(0)" ::: "memory");
    const int c = lane & 7;
#pragma unroll
    for (int j = 0; j < 4; ++j) { const int n = (lane >> 3) + 8 * j; const LAS float* s = scr + (8 * c) * 33 + n;
        u32x4 o; o.x = pk2(s[0 * 33], s[1 * 33]); o.y = pk2(s[2 * 33], s[3 * 33]); o.z = pk2(s[4 * 33], s[5 * 33]); o.w = pk2(s[6 * 33], s[7 * 33]);
        *(u32x4*)(WT + (size_t)(out_row0 + n) * ldo + k0 + 8 * c) = o; }
    asm volatile("s_waitcnt lgkmcnt(0)" ::: "memory");
}
__device__ __forceinline__ void phase_prologue(Frame& F) {
    LAS float* sc = (LAS float*)F.lds;
    LAS float* red = sc + 9 * 1024;
    for (int i = F.tid; i < 9 * 1024; i += NTHREADS) { const float v = (i < 8192) ? F.in[I_C][i] : F.in[I_CCTX][i - 8192]; sc[i] = silu_f(v); }
    __syncthreads();
    for (int it = blockIdx.x; it < 192; it += F.G) {
        const int kc = it & 3, cb = (it >> 2) % 24, l = it / 96;
        const float* W = F.in[I_ADAW] + (size_t)l * 1024 * 6144 + cb * 256 + 4 * F.lane;
        const int k0 = kc * 256 + F.wave * 32;
        f32x4 acc[9];
#pragma unroll
        for (int r = 0; r < 9; ++r) acc[r] = (f32x4){0.f, 0.f, 0.f, 0.f};
#pragma unroll 8
        for (int i = 0; i < 32; ++i) { const int k = k0 + i; const f32x4 wv = *(const f32x4*)(W + (size_t)k * 6144);
#pragma unroll
            for (int r = 0; r < 9; ++r) acc[r] += sc[r * 1024 + k] * wv; }
#pragma unroll
        for (int r = 0; r < 9; ++r) *(LAS f32x4*)(red + (F.wave * 9 + r) * 256 + 4 * F.lane) = acc[r];
        __syncthreads();
        for (int idx = F.tid; idx < 2304; idx += NTHREADS) { const int r = idx >> 8, ci = idx & 255; float s = 0.f;
#pragma unroll
            for (int w = 0; w < 8; ++w) s += red[(w * 9 + r) * 256 + ci];
            F.modp[(size_t)((kc * 2 + l) * 9 + r) * 6144 + cb * 256 + ci] = s; }
        __syncthreads();
    }
    __syncthreads();
    LAS float* scr = (LAS float*)(F.lds + F.wave * 16384);
    const int gw = blockIdx.x * NWAVES + F.wave, NGW = F.G * NWAVES;
    constexpr int I_IN = 16 * 128, I_OUT = 32 * 32, I_QKV = 16 * 48, I_WO = 16 * 32, I_MOE = 32 * 768;
    constexpr int NITEMS = I_IN + I_OUT + I_QKV + I_WO + I_MOE;
    for (int it = gw; it < NITEMS; it += NGW) {
        int r = it;
        if (r < I_IN) { const int kb = r / 128, nb = r % 128; transpose_item(F.in[I_AWIN], 4096, kb * 64, nb * 32, F.win, 1024, nb * 32, scr, F.lane); continue; } r -= I_IN;
        if (r < I_OUT) { const int kb = r / 32, nb = r % 32; transpose_item(F.in[I_AWOUT], 1024, kb * 64, nb * 32, F.wout, 2048, nb * 32, scr, F.lane); continue; } r -= I_OUT;
        if (r < I_QKV) { const int kb = r / 48, nb = r % 48; transpose_item(F.in[I_BQKV], 1536, kb * 64, nb * 32, F.wqkv, 1024, nb * 32, scr, F.lane); continue; } r -= I_QKV;
        if (r < I_WO) { const int kb = r / 32, nb = r % 32; transpose_item(F.in[I_BWO], 1024, kb * 64, nb * 32, F.wo, 1024, nb * 32, scr, F.lane); continue; } r -= I_WO;
        const int le = r / 768, q = r % 768;
        if (q < 512) { const int up = q >> 8, qq = q & 255, kb = qq / 16, nb = qq % 16, n0 = nb * 32;
            const float* W = F.in[up ? I_MU : I_MG] + (size_t)le * 1024 * 512;
            transpose_item(W, 512, kb * 64, n0, F.gu + (size_t)le * 1024 * 1024, 1024, n0 + (n0 / 128) * 128 + up * 128, scr, F.lane); }
        else { const int qq = q - 512, kb = qq / 32, nb = qq % 32;
            transpose_item(F.in[I_MD] + (size_t)le * 512 * 1024, 1024, kb * 64, nb * 32, F.dn + (size_t)le * 1024 * 512, 512, nb * 32, scr, F.lane); }
    }
    for (int i = blockIdx.x * NTHREADS + F.tid; i < 8 * 128 * 128; i += F.G * NTHREADS) F.wsbf[i] = (bf16_t)f2bf(F.in[I_AWS][i]);
}

__device__ __forceinline__ void load_row(const float* row, int lane, f32x4 (&v)[4]) {
#pragma unroll
    for (int j = 0; j < 4; ++j) v[j] = *(const f32x4*)(row + 4 * lane + 256 * j);
}
__device__ __forceinline__ float row_sumsq(const f32x4 (&v)[4]) {
    float s = 0.f;
#pragma unroll
    for (int j = 0; j < 4; ++j) s += (v[j].x * v[j].x + v[j].y * v[j].y) + (v[j].z * v[j].z + v[j].w * v[j].w);
    return wave_sum(s);
}
__device__ __forceinline__ void store_row_bf16(bf16_t* row, int lane, const f32x4 (&v)[4]) {
#pragma unroll
    for (int j = 0; j < 4; ++j) { u32x2 o; o.x = pk2(v[j].x, v[j].y); o.y = pk2(v[j].z, v[j].w); *(u32x2*)(row + 4 * lane + 256 * j) = o; }
}
__device__ __forceinline__ void phase_norm1_l0(Frame& F) {
    for (int idx = blockIdx.x * NTHREADS + F.tid; idx < 2 * 9 * 6144; idx += F.G * NTHREADS) { const int l = idx / 55296, rem = idx % 55296; F.modf[idx] = mod_from_partials(F, l, rem / 6144, rem % 6144); }
    LAS float* lm = (LAS float*)F.lds;
    const int per = (NT + F.G - 1) / F.G; const int r0 = blockIdx.x * per; int r1 = r0 + per; if (r1 > NT) r1 = NT;
    int lo = r0;
    while (lo < r1) {
        const int grp = lo / 2048; int hi = (grp + 1) * 2048; if (hi > r1) hi = r1;
        __syncthreads();
        for (int n = F.tid; n < 2048; n += NTHREADS) lm[n] = mod_from_partials(F, 0, grp, n);
        __syncthreads();
        for (int row = lo + F.wave; row < hi; row += NWAVES) {
            f32x4 v[4]; load_row(xin_row(F, row), F.lane, v);
            const float rstd = rsqrtf(row_sumsq(v) * (1.f / D) + EPS);
#pragma unroll
            for (int j = 0; j < 4; ++j) { const int c = 4 * F.lane + 256 * j; const f32x4 g = *(const f32x4*)(F.in[I_N1G] + c);
                const f32x4 sh = *(const LAS f32x4*)(lm + c), sc = *(const LAS f32x4*)(lm + 1024 + c);
                v[j] = v[j] * rstd * g * (sc + 1.f) + sh; }
            store_row_bf16(F.h + (size_t)row * D, F.lane, v);
        }
        lo = hi;
    }
}
__device__ __forceinline__ void phase_norm2_route(Frame& F, int l, int nrows) {
    const int gw = blockIdx.x * NWAVES + F.wave, NGW = F.G * NWAVES;
    unsigned* cnt = F.ctl + CW_CNT + 16 * l;
    for (int row = gw; row < nrows; row += NGW) {
        f32x4 v[4]; load_row(xb_row(F, row), F.lane, v);
        const float rstd = rsqrtf(row_sumsq(v) * (1.f / D) + EPS);
        const float* mf = F.modf + (size_t)(l * 9 + row / 2048) * 6144;
        float lg[16];
#pragma unroll
        for (int e = 0; e < 16; ++e) lg[e] = 0.f;
#pragma unroll
        for (int j = 0; j < 4; ++j) { const int c = 4 * F.lane + 256 * j; const f32x4 g = *(const f32x4*)(F.in[I_N2G] + l * D + c);
            const f32x4 sh = *(const f32x4*)(mf + 3072 + c), sc = *(const f32x4*)(mf + 4096 + c);
            v[j] = v[j] * rstd * g * (sc + 1.f) + sh;
#pragma unroll
            for (int i = 0; i < 4; ++i) { const float hv = v[j][i]; const float* wr = F.in[I_RW] + (size_t)(c + i) * 16;
#pragma unroll
                for (int e4 = 0; e4 < 4; ++e4) { const f32x4 w = *(const f32x4*)(wr + 4 * e4); lg[4 * e4] += hv * w.x; lg[4 * e4 + 1] += hv * w.y; lg[4 * e4 + 2] += hv * w.z; lg[4 * e4 + 3] += hv * w.w; } } }
        store_row_bf16(F.h + (size_t)row * D, F.lane, v);
        float s[16], sb[16];
#pragma unroll
        for (int e = 0; e < 16; ++e) { lg[e] = wave_sum(lg[e]); s[e] = sigmoid_f(lg[e]); sb[e] = s[e] + F.in[I_RB][e]; }
        float gs[4];
#pragma unroll
        for (int g = 0; g < 4; ++g) { const float a = sb[4 * g], b = sb[4 * g + 1], c = sb[4 * g + 2], d = sb[4 * g + 3];
            const float m1 = fmaxf(fmaxf(a, b), fmaxf(c, d));
            const float hi_ab = fmaxf(a, b), lo_ab = fminf(a, b), hi_cd = fmaxf(c, d), lo_cd = fminf(c, d);
            const float m2 = (hi_ab >= hi_cd) ? fmaxf(lo_ab, hi_cd) : fmaxf(lo_cd, hi_ab);
            gs[g] = m1 + m2; }
        int best = 0; float bv = gs[0];
#pragma unroll
        for (int g = 1; g < 4; ++g) if (gs[g] > bv) { bv = gs[g]; best = g; }
        float q[4], qs[4];
#pragma unroll
        for (int j = 0; j < 4; ++j) { q[j] = best == 0 ? sb[j] : best == 1 ? sb[4 + j] : best == 2 ? sb[8 + j] : sb[12 + j]; qs[j] = best == 0 ? s[j] : best == 1 ? s[4 + j] : best == 2 ? s[8 + j] : s[12 + j]; }
        int i1 = 0; float v1 = q[0];
#pragma unroll
        for (int j = 1; j < 4; ++j) if (q[j] > v1) { v1 = q[j]; i1 = j; }
        int i2 = -1; float v2 = -INFINITY;
#pragma unroll
        for (int j = 0; j < 4; ++j) if (j != i1 && q[j] > v2) { v2 = q[j]; i2 = j; }
        const float w1 = i1 == 0 ? qs[0] : i1 == 1 ? qs[1] : i1 == 2 ? qs[2] : qs[3];
        const float w2 = i2 == 0 ? qs[0] : i2 == 1 ? qs[1] : i2 == 2 ? qs[2] : qs[3];
        const float inv = 1.f / (w1 + w2);
        if (F.lane == 0) {
            const int e0 = best * 4 + i1, e1 = best * 4 + i2;
            const int p0 = (int)atomicAdd(cnt + e0, 1u), p1 = (int)atomicAdd(cnt + e1, 1u);
            F.list[(size_t)e0 * NT + p0] = row; F.list[(size_t)e1 * NT + p1] = row;
            F.toke[2 * row] = e0; F.toke[2 * row + 1] = e1; F.tokp[2 * row] = p0; F.tokp[2 * row + 1] = p1;
            F.tokw[2 * row] = w1 * inv; F.tokw[2 * row + 1] = w2 * inv;
        }
    }
}
__device__ __forceinline__ int expert_off(const unsigned* cnt, int e) { int o = 0; for (int j = 0; j < e; ++j) o += ((int)cnt[j] + 255) & ~255; return o; }
template <bool FINAL> __device__ __forceinline__ void phase_combine(Frame& F, int l, int nrows) {
    const int gw = blockIdx.x * NWAVES + F.wave, NGW = F.G * NWAVES;
    const unsigned* cnt = F.ctl + CW_CNT + 16 * l;
    for (int row = gw; row < nrows; row += NGW) {
        float* xr = xb_row(F, row);
        f32x4 v[4]; load_row(xr, F.lane, v);
        const int e0 = F.toke[2 * row], e1 = F.toke[2 * row + 1];
        const int s0 = expert_off(cnt, e0) + F.tokp[2 * row], s1 = expert_off(cnt, e1) + F.tokp[2 * row + 1];
        const float w0 = F.tokw[2 * row], w1 = F.tokw[2 * row + 1];
        const float* mf = F.modf + (size_t)(l * 9 + row / 2048) * 6144;
        const bf16_t* y0 = F.y + (size_t)s0 * D; const bf16_t* y1 = F.y + (size_t)s1 * D;
#pragma unroll
        for (int j = 0; j < 4; ++j) { const int c = 4 * F.lane + 256 * j; const f32x4 g2 = *(const f32x4*)(mf + 5120 + c);
            const u32x2 a = *(const u32x2*)(y0 + c), b = *(const u32x2*)(y1 + c);
            f32x4 m; m.x = w0 * __uint_as_float(a.x << 16) + w1 * __uint_as_float(b.x << 16); m.y = w0 * __uint_as_float(a.x & 0xffff0000u) + w1 * __uint_as_float(b.x & 0xffff0000u);
            m.z = w0 * __uint_as_float(a.y << 16) + w1 * __uint_as_float(b.y << 16); m.w = w0 * __uint_as_float(a.y & 0xffff0000u) + w1 * __uint_as_float(b.y & 0xffff0000u);
            v[j] = v[j] + g2 * m; }
        const float rstd = rsqrtf(row_sumsq(v) * (1.f / D) + EPS);
        if (FINAL) {
#pragma unroll
            for (int j = 0; j < 4; ++j) { const int c = 4 * F.lane + 256 * j; const f32x4 g = *(const f32x4*)(F.in[I_FG] + c); *(f32x4*)(F.out + (size_t)row * D + c) = v[j] * rstd * g; }
        } else {
#pragma unroll
            for (int j = 0; j < 4; ++j) *(f32x4*)(xr + 4 * F.lane + 256 * j) = v[j];
            const float* mn = F.modf + (size_t)((l + 1) * 9 + row / 2048) * 6144;
#pragma unroll
            for (int j = 0; j < 4; ++j) { const int c = 4 * F.lane + 256 * j; const f32x4 g = *(const f32x4*)(F.in[I_N1G] + (l + 1) * D + c);
                const f32x4 sh = *(const f32x4*)(mn + c), sc = *(const f32x4*)(mn + 1024 + c);
                v[j] = v[j] * rstd * g * (sc + 1.f) + sh; }
            store_row_bf16(F.h + (size_t)row * D, F.lane, v);
        }
    }
}

template <int NBM, class AR, class BR0, class BR1, class EPI>
__device__ __forceinline__ void ngemm_unit(LAS unsigned char* lds, int tid, AR arow, BR0 brow0, BR1 brow1, int K, EPI epi) {
    const int lane = tid & 63, wave = tid >> 6, wr = wave >> 2, wc = wave & 3, fr = lane & 15, fq = lane >> 4;
    LAS bf16_t* As = (LAS bf16_t*)lds; LAS bf16_t* Bs0 = As + 128 * 40; LAS bf16_t* Bs1 = Bs0 + 128 * 40;
    const int lr = tid >> 2, lc = (tid & 3) * 8;
    const bf16_t* ap = arow(lr) + lc; const bf16_t* bp0 = brow0(lr) + lc; const bf16_t* bp1 = brow1(lr) + lc;
    f32x4 acc0[4][2], acc1[4][2];
#pragma unroll
    for (int m = 0; m < 4; ++m)
#pragma unroll
        for (int n = 0; n < 2; ++n) { acc0[m][n] = (f32x4){0.f, 0.f, 0.f, 0.f}; acc1[m][n] = (f32x4){0.f, 0.f, 0.f, 0.f}; }
    for (int k0 = 0; k0 < K; k0 += 32) {
        const u32x4 va = *(const u32x4*)(ap + k0), vb0 = *(const u32x4*)(bp0 + k0); u32x4 vb1 = va; if (NBM > 1) vb1 = *(const u32x4*)(bp1 + k0);
        __syncthreads();
        *(LAS u32x4*)(As + lr * 40 + lc) = va; *(LAS u32x4*)(Bs0 + lr * 40 + lc) = vb0; if (NBM > 1) *(LAS u32x4*)(Bs1 + lr * 40 + lc) = vb1;
        __syncthreads();
        bf16x8 a[4], b0[2], b1[2];
#pragma unroll
        for (int m = 0; m < 4; ++m) a[m] = *(const LAS bf16x8*)(As + (wr * 64 + m * 16 + fr) * 40 + fq * 8);
#pragma unroll
        for (int n = 0; n < 2; ++n) { b0[n] = *(const LAS bf16x8*)(Bs0 + (wc * 32 + n * 16 + fr) * 40 + fq * 8); if (NBM > 1) b1[n] = *(const LAS bf16x8*)(Bs1 + (wc * 32 + n * 16 + fr) * 40 + fq * 8); else b1[n] = b0[n]; }
#pragma unroll
        for (int m = 0; m < 4; ++m)
#pragma unroll
            for (int n = 0; n < 2; ++n) { acc0[m][n] = __builtin_amdgcn_mfma_f32_16x16x32_bf16(a[m], b0[n], acc0[m][n], 0, 0, 0);
                if (NBM > 1) acc1[m][n] = __builtin_amdgcn_mfma_f32_16x16x32_bf16(a[m], b1[n], acc1[m][n], 0, 0, 0); }
    }
#pragma unroll
    for (int m = 0; m < 4; ++m)
#pragma unroll
        for (int n = 0; n < 2; ++n)
#pragma unroll
            for (int j = 0; j < 4; ++j) epi(wr * 64 + m * 16 + fq * 4 + j, wc * 32 + n * 16 + fr, acc0[m][n][j], acc1[m][n][j]);
    __syncthreads();
}

__device__ __forceinline__ void phase_gemm1_naive(Frame& F) {
    for (int u = blockIdx.x; u < 144 * 32; u += F.G) {
        const int mt = u / 32, nt = u % 32;
        const bf16_t* A = F.h + (size_t)mt * 128 * D; const bf16_t* B = F.win + (size_t)nt * 128 * D;
        bf16_t* U = F.u; bf16_t* VT = F.vt;
        ngemm_unit<1>(F.lds, F.tid, [=](int r) { return A + (size_t)r * D; }, [=](int n) { return B + (size_t)n * D; }, [=](int n) { return B + (size_t)n * D; }, D,
            [=](int r, int c, float v, float) { const int row = mt * 128 + r, col = nt * 128 + c; const float g = gelu_tanh(v);
                if (col < AW) U[(size_t)row * AW + col] = (bf16_t)f2bf(g); else VT[(size_t)(col - AW) * NT + row] = (bf16_t)f2bf(g); });
    }
}
__device__ __forceinline__ void phase_vsq_naive(Frame& F) {
    for (int tok = blockIdx.x * NTHREADS + F.tid; tok < NT; tok += F.G * NTHREADS) {
        float s = 0.f;
        for (int ch = 0; ch < AW; ++ch) { const float v = bf2f(F.vt[(size_t)ch * NT + tok]); s += v * v; }
        F.vsq[(size_t)tok * 32] = s;
        for (int j = 1; j < 32; ++j) F.vsq[(size_t)tok * 32 + j] = 0.f;
    }
}
__device__ __forceinline__ void phase_vnorm_naive(Frame& F) {
    for (int tok = blockIdx.x * NTHREADS + F.tid; tok < NT; tok += F.G * NTHREADS) {
        float s = 0.f;
        for (int j = 0; j < 32; ++j) s += F.vsq[(size_t)tok * 32 + j];
        const float rstd = rsqrtf(s * (1.f / AW) + EPS);
        for (int ch = 0; ch < AW; ++ch) { const size_t i = (size_t)ch * NT + tok; F.vt[i] = (bf16_t)f2bf(bf2f(F.vt[i]) * rstd * F.in[I_AGV][ch]); }
    }
}
__device__ __forceinline__ void phase_sgu_naive(Frame& F) {
    for (int u = blockIdx.x; u < 144 * 16; u += F.G) {
        const int c = u / 16, g = (u % 16) >> 1, nh = u & 1;
        const bf16_t* A = F.wsbf + (size_t)g * 128 * 128; const bf16_t* B = F.vt + (size_t)(g * 256 + nh * 128) * NT + (size_t)c * 128;
        bf16_t* U = F.u; const float* bs = F.in[I_ABS] + g * 128;
        ngemm_unit<1>(F.lds, F.tid, [=](int r) { return A + (size_t)r * 128; }, [=](int n) { return B + (size_t)n * NT; }, [=](int n) { return B + (size_t)n * NT; }, 128,
            [=](int r, int ci, float v, float) { const size_t i = (size_t)(c * 128 + r) * AW + g * 256 + nh * 128 + ci; U[i] = (bf16_t)f2bf(bf2f(U[i]) * (v + bs[r])); });
    }
}
__device__ __forceinline__ void phase_gemm2_naive(Frame& F) {
    for (int u = blockIdx.x; u < 144 * 8; u += F.G) {
        const int mt = u / 8, nt = u % 8;
        const bf16_t* A = F.u + (size_t)mt * 128 * AW; const bf16_t* B = F.wout + (size_t)nt * 128 * AW;
        float* out = F.out; float* cx = F.cx; const float* x0 = F.in[I_X]; const float* c0 = F.in[I_CTX]; const float* mf = F.modf;
        ngemm_unit<1>(F.lds, F.tid, [=](int r) { return A + (size_t)r * AW; }, [=](int n) { return B + (size_t)n * AW; }, [=](int n) { return B + (size_t)n * AW; }, AW,
            [=](int r, int c, float v, float) { const int row = mt * 128 + r, col = nt * 128 + c; const float g1 = mf[(size_t)(row / 2048) * 6144 + 2048 + col];
                if (row < NX) out[(size_t)row * D + col] = x0[(size_t)row * D + col] + g1 * v; else cx[(size_t)(row - NX) * D + col] = c0[(size_t)(row - NX) * D + col] + g1 * v; });
    }
}
__device__ __forceinline__ void phase_gateup_naive(Frame& F, int l) {
    const unsigned* cnt = F.ctl + CW_CNT + 16 * l;
    int ubase = 0, off = 0;
    for (int e = 0; e < NE; ++e) {
        const int n = (int)cnt[e], mt128 = ((n + 255) >> 8) * 2, nu = mt128 * 4;
        int u = blockIdx.x; if (u < ubase) u += ((ubase - u + F.G - 1) / F.G) * F.G;
        for (; u < ubase + nu; u += F.G) {
            const int lu = u - ubase, mt = lu >> 2, pn = lu & 3;
            const int* lst = F.list + (size_t)e * NT; const bf16_t* H = F.h; const bf16_t* B = F.gu + (size_t)(l * 16 + e) * 1024 * 1024 + (size_t)pn * 256 * 1024;
            bf16_t* HID = F.hid + (size_t)(off + mt * 128) * DE + pn * 128;
            ngemm_unit<2>(F.lds, F.tid, [=](int r) { const int sr = mt * 128 + r; const int tok = lst[sr < n ? sr : 0]; return H + (size_t)tok * D; },
                [=](int c) { return B + (size_t)c * 1024; }, [=](int c) { return B + (size_t)(128 + c) * 1024; }, D,
                [=](int r, int c, float g, float up) { HID[(size_t)r * DE + c] = (bf16_t)f2bf(silu_f(g) * up); });
        }
        ubase += nu; off += (n + 255) & ~255;
    }
}
__device__ __forceinline__ void phase_down_naive(Frame& F, int l) {
    const unsigned* cnt = F.ctl + CW_CNT + 16 * l;
    int ubase = 0, off = 0;
    for (int e = 0; e < NE; ++e) {
        const int n = (int)cnt[e], mt128 = ((n + 255) >> 8) * 2, nu = mt128 * 8;
        int u = blockIdx.x; if (u < ubase) u += ((ubase - u + F.G - 1) / F.G) * F.G;
        for (; u < ubase + nu; u += F.G) {
            const int lu = u - ubase, mt = lu >> 3, nt = lu & 7;
            const bf16_t* A = F.hid + (size_t)(off + mt * 128) * DE; const bf16_t* B = F.dn + (size_t)(l * 16 + e) * 1024 * 512 + (size_t)nt * 128 * 512;
            bf16_t* Y = F.y + (size_t)(off + mt * 128) * D + nt * 128;
            ngemm_unit<1>(F.lds, F.tid, [=](int r) { return A + (size_t)r * DE; }, [=](int c) { return B + (size_t)c * DE; }, [=](int c) { return B + (size_t)c * DE; }, DE,
                [=](int r, int c, float v, float) { Y[(size_t)r * D + c] = (bf16_t)f2bf(v); });
        }
        ubase += nu; off += (n + 255) & ~255;
    }
}
__device__ __forceinline__ void phase_qkv_naive(Frame& F) {
    for (int u = blockIdx.x; u < 144 * 12; u += F.G) {
        const int mt = u / 12, nt = u % 12;
        if (mt >= 128 && nt < 8) continue;
        const bf16_t* A = F.h + (size_t)mt * 128 * D; const bf16_t* B = F.wqkv + (size_t)nt * 128 * D;
        bf16_t *Q = F.q, *K = F.k, *V = F.v;
        ngemm_unit<1>(F.lds, F.tid, [=](int r) { return A + (size_t)r * D; }, [=](int n) { return B + (size_t)n * D; }, [=](int n) { return B + (size_t)n * D; }, D,
            [=](int r, int c, float v, float) { const int row = mt * 128 + r, col = nt * 128 + c;
                if (col < 1024) Q[(size_t)row * 1024 + col] = (bf16_t)f2bf(v); else if (col < 1280) K[(size_t)row * KVD + col - 1024] = (bf16_t)f2bf(v); else V[(size_t)row * KVD + col - 1280] = (bf16_t)f2bf(v); });
    }
}
__device__ __forceinline__ void phase_rope_naive(Frame& F) {
    for (int idx = blockIdx.x * NTHREADS + F.tid; idx < NX * 640; idx += F.G * NTHREADS) {
        const int f = idx & 15, a = (idx >> 4) & 1, hs = (idx >> 5) % 20, row = idx / 640;
        bf16_t* p = hs < 16 ? F.q + (size_t)row * 1024 + hs * 64 : F.k + (size_t)row * KVD + (hs - 16) * 64;
        const float x1 = bf2f(p[a * 32 + f]), x2 = bf2f(p[a * 32 + 16 + f]);
        const int pos = row & 2047; const float pp = (float)(a ? (pos & 63) : (pos >> 6));
        const float inv = exp2f(-(float)f * (13.287712379549449f / 16.f));
        float rev = pp * inv * 0.15915494309189535f; rev -= floorf(rev);
        const float sn = __builtin_amdgcn_sinf(rev), cs = __builtin_amdgcn_cosf(rev);
        const float sc = hs < 16 ? QSCALE : 1.f;
        p[a * 32 + f] = (bf16_t)f2bf((x1 * cs - x2 * sn) * sc); p[a * 32 + 16 + f] = (bf16_t)f2bf((x2 * cs + x1 * sn) * sc);
    }
}
__device__ __forceinline__ void phase_attn_naive(Frame& F) {
    for (int idx = blockIdx.x * NTHREADS + F.tid; idx < NX * 16; idx += F.G * NTHREADS) {
        const int pos = idx & 2047, head = (idx >> 11) & 15, b = idx >> 15, hk = head >> 2;
        const int row = b * SEQ + pos;
        float q[64], o[64];
        { const bf16_t* qp = F.q + (size_t)row * 1024 + head * 64;
#pragma unroll
          for (int d8 = 0; d8 < 8; ++d8) { const u32x4 w = *(const u32x4*)(qp + 8 * d8);
#pragma unroll
              for (int i = 0; i < 4; ++i) { q[8 * d8 + 2 * i] = __uint_as_float(w[i] << 16); q[8 * d8 + 2 * i + 1] = __uint_as_float(w[i] & 0xffff0000u); } } }
#pragma unroll
        for (int d = 0; d < 64; ++d) o[d] = 0.f;
        float m = F.in[I_BSINK][head] * LOG2E, lsum = 1.f;
        const int w_lo = pos - 128 < 0 ? 0 : pos - 128, w_hi = pos + 128 > SEQ - 1 ? SEQ - 1 : pos + 128;
        const int nwin = w_hi - w_lo + 1;
        for (int j = 0; j < CTXL + nwin; ++j) {
            const int krow = j < CTXL ? NX + b * CTXL + j : b * SEQ + w_lo + (j - CTXL);
            const bf16_t* kp = F.k + (size_t)krow * KVD + hk * 64; const bf16_t* vp = F.v + (size_t)krow * KVD + hk * 64;
            float s = 0.f;
#pragma unroll
            for (int d8 = 0; d8 < 8; ++d8) { const u32x4 w = *(const u32x4*)(kp + 8 * d8);
#pragma unroll
                for (int i = 0; i < 4; ++i) { s += q[8 * d8 + 2 * i] * __uint_as_float(w[i] << 16); s += q[8 * d8 + 2 * i + 1] * __uint_as_float(w[i] & 0xffff0000u); } }
            const float mn = fmaxf(m, s), f = exp2f(m - mn), pj = exp2f(s - mn);
            lsum = lsum * f + pj; m = mn;
#pragma unroll
            for (int d8 = 0; d8 < 8; ++d8) { const u32x4 w = *(const u32x4*)(vp + 8 * d8);
#pragma unroll
                for (int i = 0; i < 4; ++i) { o[8 * d8 + 2 * i] = o[8 * d8 + 2 * i] * f + pj * __uint_as_float(w[i] << 16); o[8 * d8 + 2 * i + 1] = o[8 * d8 + 2 * i + 1] * f + pj * __uint_as_float(w[i] & 0xffff0000u); } }
        }
        const float il = 1.f / lsum;
        bf16_t* op = F.o + (size_t)row * 1024 + head * 64;
#pragma unroll
        for (int d8 = 0; d8 < 8; ++d8) { u32x4 w;
#pragma unroll
            for (int i = 0; i < 4; ++i) w[i] = pk2(o[8 * d8 + 2 * i] * il, o[8 * d8 + 2 * i + 1] * il);
            *(u32x4*)(op + 8 * d8) = w; }
    }
}
__device__ __forceinline__ void phase_wo_naive(Frame& F) {
    for (int u = blockIdx.x; u < 128 * 8; u += F.G) {
        const int mt = u / 8, nt = u % 8;
        const bf16_t* A = F.o + (size_t)mt * 128 * D; const bf16_t* B = F.wo + (size_t)nt * 128 * D;
        float* out = F.out; const float* mf = F.modf + (size_t)9 * 6144;
        ngemm_unit<1>(F.lds, F.tid, [=](int r) { return A + (size_t)r * D; }, [=](int n) { return B + (size_t)n * D; }, [=](int n) { return B + (size_t)n * D; }, D,
            [=](int r, int c, float v, float) { const int row = mt * 128 + r, col = nt * 128 + c; const float g1 = mf[(size_t)(row / 2048) * 6144 + 2048 + col];
                out[(size_t)row * D + col] += g1 * v; });
    }
}

constexpr int N_PHASES = 19;
__global__ void __launch_bounds__(NTHREADS, 2) fwd_kernel(Params args) {
    extern __shared__ __attribute__((aligned(16))) unsigned char lds_raw[];
    Frame F;
#pragma unroll
    for (int i = 0; i < 22; ++i) F.in[i] = args.in[i];
    F.out = args.out; F.ws = args.ws; F.lds = (LAS unsigned char*)lds_raw;
    F.tid = threadIdx.x; F.lane = F.tid & 63; F.wave = __builtin_amdgcn_readfirstlane(F.tid >> 6); F.G = gridDim.x;
    unsigned char* ws = args.ws;
    F.ctl = (unsigned*)(ws + WS_CTL); F.modp = (float*)(ws + WS_MODP); F.modf = (float*)(ws + WS_MODF);
    F.toke = (int*)(ws + WS_TOKE); F.tokp = (int*)(ws + WS_TOKP); F.tokw = (float*)(ws + WS_TOKW); F.list = (int*)(ws + WS_LIST); F.vsq = (float*)(ws + WS_VSQ);
    F.wsbf = (bf16_t*)(ws + WS_WSBF); F.win = (bf16_t*)(ws + WS_WIN); F.wout = (bf16_t*)(ws + WS_WOUT); F.wqkv = (bf16_t*)(ws + WS_WQKV); F.wo = (bf16_t*)(ws + WS_WO);
    F.gu = (bf16_t*)(ws + WS_GU); F.dn = (bf16_t*)(ws + WS_DN); F.h = (bf16_t*)(ws + WS_H); F.cx = (float*)(ws + WS_CX);
    F.u = (bf16_t*)(ws + WS_U); F.vt = (bf16_t*)(ws + WS_VT); F.hid = (bf16_t*)(ws + WS_HID); F.y = (bf16_t*)(ws + WS_Y);
    F.q = (bf16_t*)(ws + WS_Q); F.k = (bf16_t*)(ws + WS_K); F.v = (bf16_t*)(ws + WS_V); F.o = (bf16_t*)(ws + WS_O);
    for (int u = F.tid; u < (LDS_BYTES - LDSCTL_OFF) / 4; u += NTHREADS) ((LAS unsigned*)(F.lds + LDSCTL_OFF))[u] = 0u;
    __syncthreads();
    XcdBarrier bar; bar.bar = F.ctl + CW_BAR; bar.x = 0; bar.st = nullptr;
    if (MK_N_LAUNCHES == 1) bar = xcd_barrier_post(F.ctl + CW_BAR, (volatile LAS unsigned*)(F.lds + MISC_OFF) + 8);
    const int lo = args.ph_lo, hi = args.ph_hi;
#define IN(k) (lo <= (k) && (k) < hi)
#define SEAM(k) do { if (IN(k) && IN((k) + 1)) xcd_barrier(bar); } while (0)
    if (IN(0)) { phase_prologue(F); } SEAM(0);
    if (IN(1)) { phase_norm1_l0(F); } SEAM(1);
    if (IN(2)) { phase_gemm1_naive(F); } SEAM(2);
    if (IN(3)) { phase_vsq_naive(F); } SEAM(3);
    if (IN(4)) { phase_vnorm_naive(F); } SEAM(4);
    if (IN(5)) { phase_sgu_naive(F); } SEAM(5);
    if (IN(6)) { phase_gemm2_naive(F); } SEAM(6);
    if (IN(7)) { phase_norm2_route(F, 0, NT); } SEAM(7);
    if (IN(8)) { phase_gateup_naive(F, 0); } SEAM(8);
    if (IN(9)) { phase_down_naive(F, 0); } SEAM(9);
    if (IN(10)) { phase_combine<false>(F, 0, NT); } SEAM(10);
    if (IN(11)) { phase_qkv_naive(F); } SEAM(11);
    if (IN(12)) { phase_rope_naive(F); } SEAM(12);
    if (IN(13)) { phase_attn_naive(F); } SEAM(13);
    if (IN(14)) { phase_wo_naive(F); } SEAM(14);
    if (IN(15)) { phase_norm2_route(F, 1, NX); } SEAM(15);
    if (IN(16)) { phase_gateup_naive(F, 1); } SEAM(16);
    if (IN(17)) { phase_down_naive(F, 1); } SEAM(17);
    if (IN(18)) { phase_combine<true>(F, 1, NX); }
#undef IN
#undef SEAM
}
__global__ void zero_out_kernel(float* out, int n) { for (int i = blockIdx.x * blockDim.x + threadIdx.x; i < n; i += gridDim.x * blockDim.x) out[i] = 0.f; }

extern "C" void kernel_launch(void* const* d_in, const int* in_sizes, int n_in, void* d_out, int out_size, void* d_ws, size_t ws_size, hipStream_t stream) {
    static int grid = 0;
    if (grid == 0) {
        int dev = 0, cus = 0, per_cu = 0;
        (void)hipGetDevice(&dev); (void)hipDeviceGetAttribute(&cus, hipDeviceAttributeMultiprocessorCount, dev);
        if (hipFuncSetAttribute((const void*)fwd_kernel, hipFuncAttributeMaxDynamicSharedMemorySize, LDS_BYTES) != hipSuccess) { fprintf(stderr, "kernel_launch: hipFuncSetAttribute failed\n"); }
        (void)hipOccupancyMaxActiveBlocksPerMultiprocessor(&per_cu, (const void*)fwd_kernel, NTHREADS, LDS_BYTES);
        (void)hipGetLastError();
        if (per_cu < 1) per_cu = 1;
        grid = cus > 0 ? cus : 256;
        fprintf(stderr, "kernel_launch: cus %d per_cu %d grid %d ws %zu need %zu\n", cus, per_cu, grid, ws_size, (size_t)WS_END);
    }
    if (n_in != 22 || ws_size < WS_END || out_size != NX * D) {
        zero_out_kernel<<<256, 256, 0, stream>>>((float*)d_out, out_size);
        return;
    }
    (void)hipMemsetAsync((char*)d_ws + WS_CTL, 0, CTL_ZERO_BYTES, stream);
    Params a{};
    for (int i = 0; i < 22; ++i) a.in[i] = (const float*)d_in[i];
    a.out = (float*)d_out; a.ws = (unsigned char*)d_ws;
    if (MK_N_LAUNCHES == 1) {
        a.ph_lo = 0; a.ph_hi = N_PHASES;
        void* kargs[] = {&a};
        (void)hipLaunchCooperativeKernel((const void*)fwd_kernel, dim3(grid), dim3(NTHREADS), kargs, LDS_BYTES, stream);
    } else {
        for (int ph = 0; ph < N_PHASES; ++ph) { a.ph_lo = ph; a.ph_hi = ph + 1; hipLaunchKernelGGL(fwd_kernel, dim3(grid), dim3(NTHREADS), LDS_BYTES, stream, a); }
    }
}
```

```cpp
#include <hip/hip_runtime.h>
#include <cstdint>
#include <cstdio>

#define LAS __attribute__((address_space(3)))
typedef unsigned short bf16_t;
typedef short bf16x8 __attribute__((ext_vector_type(8)));
typedef float f32x4 __attribute__((ext_vector_type(4)));
typedef float f32x2 __attribute__((ext_vector_type(2)));
typedef unsigned u32x4 __attribute__((ext_vector_type(4)));
typedef unsigned u32x2 __attribute__((ext_vector_type(2)));

#ifndef FAST_GEMM
#define FAST_GEMM 1
#endif
#ifndef FAST_ATTN
#define FAST_ATTN 1
#endif
#ifndef FAST_MIX
#define FAST_MIX FAST_GEMM
#endif
constexpr int U_LD = FAST_MIX ? 4096 : 2048;
#ifndef FAST_G2
#define FAST_G2 FAST_GEMM
#endif
#ifndef FAST_GU
#define FAST_GU FAST_GEMM
#endif
#ifndef FAST_DN
#define FAST_DN FAST_GEMM
#endif
#ifndef FAST_QKV
#define FAST_QKV FAST_GEMM
#endif
#ifndef FAST_WO
#define FAST_WO FAST_GEMM
#endif
#ifndef MK_N_LAUNCHES
#define MK_N_LAUNCHES 1
#endif

constexpr int D = 1024, NBATCH = 8, SEQ = 2048, NX = NBATCH * SEQ, CTXL = 256, NCX = NBATCH * CTXL, NT = NX + NCX;
constexpr int AW = 2048, CHUNK = 128, NGRP = 8, GW = 256;
constexpr int NE = 16, DE = 512;
constexpr int NQKV = 1536, KVD = 256, HD = 64;
constexpr float EPS = 1e-6f;
constexpr float LOG2E = 1.4426950408889634f;
constexpr float QSCALE = 0.125f * LOG2E;
constexpr int NTHREADS = 512, NWAVES = 8;
constexpr int LDS_BYTES = 163840;
constexpr int MISC_OFF = 131072 + 320;
constexpr int LDSCTL_OFF = 131072;

constexpr size_t MiB = 1u << 20;
constexpr size_t WS_CTL = 0, CTL_ZERO_BYTES = 1 * MiB;
constexpr size_t WS_MODP = 1 * MiB;
constexpr size_t WS_MODF = 3 * MiB;
constexpr size_t WS_TOKE = 4 * MiB;
constexpr size_t WS_TOKP = 4 * MiB + 256 * 1024;
constexpr size_t WS_TOKW = 4 * MiB + 512 * 1024;
constexpr size_t WS_LIST = 5 * MiB;
constexpr size_t WS_VSQ = 7 * MiB;
constexpr size_t WS_HS = 9 * MiB + 512 * 1024;
constexpr size_t WS_WSBF = 10 * MiB;
constexpr size_t WS_WIN = 11 * MiB;
constexpr size_t WS_WOUT = 19 * MiB;
constexpr size_t WS_WQKV = 23 * MiB;
constexpr size_t WS_WO = 26 * MiB;
constexpr size_t WS_GU = 28 * MiB;
constexpr size_t WS_DN = 92 * MiB;
constexpr size_t WS_H = 124 * MiB;
constexpr size_t WS_XBH = 160 * MiB;
constexpr size_t WS_OV = 196 * MiB;
constexpr size_t WS_U = WS_OV;
constexpr size_t WS_VT = WS_OV + 72 * MiB;
constexpr size_t WS_HID = WS_OV;
constexpr size_t WS_Y = WS_OV + 40 * MiB;
constexpr size_t WS_Q = WS_OV;
constexpr size_t WS_K = WS_OV + 32 * MiB;
constexpr size_t WS_V = WS_OV + 41 * MiB;
constexpr size_t WS_O = WS_OV + 50 * MiB;
constexpr size_t WS_END = WS_OV + 144 * MiB;
constexpr int CW_CNT = 64;
constexpr int CW_FILL = 1024;
constexpr int CW_AMAX_IN = 32768, CW_AMAX_QKV = CW_AMAX_IN + 4096, CW_AMAX_GU = CW_AMAX_QKV + 1536;
constexpr int CW_BAR = 4096;

__device__ __forceinline__ float bf2f(bf16_t v) { return __uint_as_float((unsigned)v << 16); }
__device__ __forceinline__ unsigned f2bf(float f) { unsigned u = __float_as_uint(f); return (u + 0x7fffu + ((u >> 16) & 1u)) >> 16; }
__device__ __forceinline__ unsigned pk2(float lo, float hi) { return f2bf(lo) | (f2bf(hi) << 16); }
__device__ __forceinline__ float wave_sum(float v) {
#pragma unroll
    for (int o = 1; o < 64; o <<= 1) v += __shfl_xor(v, o);
    return v;
}
__device__ __forceinline__ float wave_sum_dpp(float v) {
    v += __builtin_bit_cast(float, __builtin_amdgcn_update_dpp(0, __builtin_bit_cast(int, v), 0xB1, 0xf, 0xf, true));
    v += __builtin_bit_cast(float, __builtin_amdgcn_update_dpp(0, __builtin_bit_cast(int, v), 0x4E, 0xf, 0xf, true));
    v += __builtin_bit_cast(float, __builtin_amdgcn_update_dpp(0, __builtin_bit_cast(int, v), 0x141, 0xf, 0xf, true));
    v += __builtin_bit_cast(float, __builtin_amdgcn_update_dpp(0, __builtin_bit_cast(int, v), 0x140, 0xf, 0xf, true));
    v += __builtin_bit_cast(float, __builtin_amdgcn_update_dpp(0, __builtin_bit_cast(int, v), 0x142, 0xa, 0xf, false));
    v += __builtin_bit_cast(float, __builtin_amdgcn_update_dpp(0, __builtin_bit_cast(int, v), 0x143, 0xc, 0xf, false));
    return __builtin_bit_cast(float, __builtin_amdgcn_readlane(__builtin_bit_cast(int, v), 63));
}
__device__ __forceinline__ float wave_max_dpp(float v) {
    v = fmaxf(v, __builtin_bit_cast(float, __builtin_amdgcn_update_dpp(0, __builtin_bit_cast(int, v), 0xB1, 0xf, 0xf, true)));
    v = fmaxf(v, __builtin_bit_cast(float, __builtin_amdgcn_update_dpp(0, __builtin_bit_cast(int, v), 0x4E, 0xf, 0xf, true)));
    v = fmaxf(v, __builtin_bit_cast(float, __builtin_amdgcn_update_dpp(0, __builtin_bit_cast(int, v), 0x141, 0xf, 0xf, true)));
    v = fmaxf(v, __builtin_bit_cast(float, __builtin_amdgcn_update_dpp(0, __builtin_bit_cast(int, v), 0x140, 0xf, 0xf, true)));
    v = fmaxf(v, __builtin_bit_cast(float, __builtin_amdgcn_update_dpp(0, __builtin_bit_cast(int, v), 0x142, 0xa, 0xf, false)));
    v = fmaxf(v, __builtin_bit_cast(float, __builtin_amdgcn_update_dpp(0, __builtin_bit_cast(int, v), 0x143, 0xc, 0xf, false)));
    return __builtin_bit_cast(float, __builtin_amdgcn_readlane(__builtin_bit_cast(int, v), 63));
}
__device__ __forceinline__ float gelu_tanh(float x) { const float t = x * __builtin_fmaf(x * x, -0.10294324f, -2.3022082f); return x * __builtin_amdgcn_rcpf(1.f + __builtin_amdgcn_exp2f(t)); }
__device__ __forceinline__ float silu_f(float x) { return x * __builtin_amdgcn_rcpf(1.f + __builtin_amdgcn_exp2f(-1.4426950408889634f * x)); }
__device__ __forceinline__ float sigmoid_f(float x) { return __builtin_amdgcn_rcpf(1.f + __builtin_amdgcn_exp2f(-1.4426950408889634f * x)); }

#define XB_TMO      128
#define XB_XCNT(j)  (256  + 64 * (j))
#define XB_XSUB(j)  (1280 + 64 * (j))
#define XB_XGEN(j)  (2304 + 64 * (j))
#define XB_TOP      3328
#define XB_TOPGEN   3392
#define XCD_BAR_WORDS 3456
#define XB_SPIN_CAP (1u << 22)
__device__ __forceinline__ unsigned xb_ld(unsigned* p)              { return __hip_atomic_load(p, __ATOMIC_RELAXED, __HIP_MEMORY_SCOPE_AGENT); }
__device__ __forceinline__ unsigned xb_add(unsigned* p, unsigned v) { return __hip_atomic_fetch_add(p, v, __ATOMIC_RELAXED, __HIP_MEMORY_SCOPE_AGENT); }
__device__ __forceinline__ unsigned xb_xcc_id() { return (unsigned)__builtin_amdgcn_s_getreg((3 << 11) | 20) & 0xFu; }
#define XB_SPIN(cond, bar) do { unsigned _sp = 0; while (cond) { __builtin_amdgcn_s_sleep(1); \
    if ((++_sp & 255u) == 0u) { if (xb_ld(&(bar)[XB_TMO])) break; if (_sp > XB_SPIN_CAP) { atomicAdd(&(bar)[XB_TMO], 1u); break; } } } } while (0)
struct XcdBarrier { unsigned* bar; unsigned x; volatile LAS unsigned* st; };
__device__ __forceinline__ XcdBarrier xcd_barrier_post(unsigned* bar, volatile LAS unsigned* st) {
    XcdBarrier b; b.bar = bar; b.x = xb_xcc_id(); b.st = st;
    if (threadIdx.x == 0) (void)xb_add(&bar[XB_XCNT(b.x)], 1u);
    return b;
}
__device__ __forceinline__ void xcd_barrier_complete(unsigned* bar, unsigned x, unsigned& nloc, unsigned& nx) {
    const unsigned G = gridDim.x * gridDim.y * gridDim.z;
    unsigned sum, cnt, mine, sp = 0u;
    for (;;) {
        sum = 0u; cnt = 0u; mine = 0u;
#pragma unroll
        for (unsigned j = 0; j < 16; ++j) { const unsigned c = xb_ld(&bar[XB_XCNT(j)]); sum += c; cnt += (c > 0u) ? 1u : 0u; mine = (j == x) ? c : mine; }
        if (sum == G) break;
        __builtin_amdgcn_s_sleep(1);
        if ((++sp & 255u) == 0u) { if (xb_ld(&bar[XB_TMO])) break; if (sp > XB_SPIN_CAP) { atomicAdd(&bar[XB_TMO], 1u); break; } }
    }
    nloc = mine > 0u ? mine : 1u; nx = cnt > 0u ? cnt : 1u;
}
__device__ __forceinline__ void xcd_barrier(const XcdBarrier& b) {
    asm volatile("s_waitcnt vmcnt(0)" ::: "memory");
    __syncthreads();
    if (threadIdx.x == 0) {
        unsigned* bar = b.bar;
        __builtin_amdgcn_s_waitcnt(0);
        unsigned nloc = b.st[0], nx = b.st[1];
        if (nloc == 0u) { xcd_barrier_complete(bar, b.x, nloc, nx); b.st[0] = nloc; b.st[1] = nx; }
        const unsigned old = xb_add(&bar[XB_XSUB(b.x)], 1u);
        const unsigned gen = old / nloc;
        if (old + 1u == (gen + 1u) * nloc) {
            __builtin_amdgcn_fence(__ATOMIC_RELEASE, "agent");
            asm volatile("s_waitcnt vmcnt(0)" ::: "memory");
            const unsigned og = xb_add(&bar[XB_TOP], 1u);
            const unsigned tg = og / nx;
            if (og + 1u == (tg + 1u) * nx) xb_add(&bar[XB_TOPGEN], 1u);
            else XB_SPIN(xb_ld(&bar[XB_TOPGEN]) == tg, bar);
            __builtin_amdgcn_fence(__ATOMIC_ACQUIRE, "agent");
            xb_add(&bar[XB_XGEN(b.x)], 1u);
            asm volatile("s_waitcnt vmcnt(0)" ::: "memory");
        } else {
            XB_SPIN(xb_ld(&bar[XB_XGEN(b.x)]) == gen, bar);
            __builtin_amdgcn_fence(__ATOMIC_ACQUIRE, "agent");
            asm volatile("s_waitcnt vmcnt(0)" ::: "memory");
        }
    }
    __syncthreads();
}

struct Params { const float* in[22]; float* out; unsigned char* ws; int ph_lo, ph_hi; };
enum { I_X = 0, I_C, I_CTX, I_CCTX, I_ADAW, I_ADAB, I_N1G, I_N2G, I_AWIN, I_AGV, I_AWS, I_ABS, I_AWOUT, I_BQKV, I_BSINK, I_BWO, I_RW, I_RB, I_MG, I_MU, I_MD, I_FG };

struct Frame {
    const float* const* in; float* out; unsigned char* ws;
    LAS unsigned char* lds;
    int tid, lane, wave, G;
    __device__ __forceinline__ unsigned* ctl() const { return (unsigned*)(ws + WS_CTL); }
    __device__ __forceinline__ float* modp() const { return (float*)(ws + WS_MODP); }
    __device__ __forceinline__ float* modf() const { return (float*)(ws + WS_MODF); }
    __device__ __forceinline__ int* toke() const { return (int*)(ws + WS_TOKE); }
    __device__ __forceinline__ int* tokp() const { return (int*)(ws + WS_TOKP); }
    __device__ __forceinline__ float* tokw() const { return (float*)(ws + WS_TOKW); }
    __device__ __forceinline__ int* list() const { return (int*)(ws + WS_LIST); }
    __device__ __forceinline__ float* vsq() const { return (float*)(ws + WS_VSQ); }
    __device__ __forceinline__ bf16_t* wsbf() const { return (bf16_t*)(ws + WS_WSBF); }
    __device__ __forceinline__ bf16_t* win() const { return (bf16_t*)(ws + WS_WIN); }
    __device__ __forceinline__ bf16_t* wout() const { return (bf16_t*)(ws + WS_WOUT); }
    __device__ __forceinline__ bf16_t* wqkv() const { return (bf16_t*)(ws + WS_WQKV); }
    __device__ __forceinline__ bf16_t* wo() const { return (bf16_t*)(ws + WS_WO); }
    __device__ __forceinline__ bf16_t* gu() const { return (bf16_t*)(ws + WS_GU); }
    __device__ __forceinline__ bf16_t* dn() const { return (bf16_t*)(ws + WS_DN); }
    __device__ __forceinline__ bf16_t* h() const { return (bf16_t*)(ws + WS_H); }
    __device__ __forceinline__ signed char* hq() const { return (signed char*)(ws + WS_H); }
    __device__ __forceinline__ float* hs() const { return (float*)(ws + WS_HS); }
    __device__ __forceinline__ float* cxp() const { return (float*)(ws + WS_H + 18 * MiB); }
    __device__ __forceinline__ signed char* winq() const { return (signed char*)(ws + WS_WIN); }
    __device__ __forceinline__ unsigned* amax_in() const { return ctl() + CW_AMAX_IN; }
    __device__ __forceinline__ unsigned* amax_qkv() const { return ctl() + CW_AMAX_QKV; }
    __device__ __forceinline__ unsigned* amax_gu() const { return ctl() + CW_AMAX_GU; }
    __device__ __forceinline__ signed char* wqkvq() const { return (signed char*)(ws + WS_WQKV); }
    __device__ __forceinline__ signed char* guq() const { return (signed char*)(ws + WS_GU); }
    __device__ __forceinline__ bf16_t* xbh() const { return (bf16_t*)(ws + WS_XBH); }
    __device__ __forceinline__ bf16_t* u() const { return (bf16_t*)(ws + WS_U); }
    __device__ __forceinline__ bf16_t* vt() const { return (bf16_t*)(ws + WS_VT); }
    __device__ __forceinline__ bf16_t* hid() const { return (bf16_t*)(ws + WS_HID); }
    __device__ __forceinline__ bf16_t* y() const { return (bf16_t*)(ws + WS_Y); }
    __device__ __forceinline__ bf16_t* q() const { return (bf16_t*)(ws + WS_Q); }
    __device__ __forceinline__ bf16_t* k() const { return (bf16_t*)(ws + WS_K); }
    __device__ __forceinline__ bf16_t* v() const { return (bf16_t*)(ws + WS_V); }
    __device__ __forceinline__ bf16_t* o() const { return (bf16_t*)(ws + WS_O); }
};

__device__ __forceinline__ bf16_t* xb_row(const Frame& F, int row) { return F.xbh() + (size_t)row * D; }
__device__ __forceinline__ const float* xin_row(const Frame& F, int row) { return row < NX ? F.in[I_X] + (size_t)row * D : F.in[I_CTX] + (size_t)(row - NX) * D; }
__device__ __forceinline__ float mod_from_partials(const Frame& F, int l, int r, int n) {
    float s = F.in[I_ADAB][l * 6144 + n];
#pragma unroll
    for (int kc = 0; kc < 4; ++kc) s += F.modp()[(size_t)((kc * 2 + l) * 9 + r) * 6144 + n];
    return s;
}

__device__ __forceinline__ void transpose_item(const float* W, int ldw, int k0, int n0, bf16_t* WT, int ldo, int out_row0, LAS float* scr, int lane) {
#pragma unroll 8
    for (int i = 0; i < 32; ++i) { const int kk = 2 * i + (lane >> 5); scr[kk * 33 + (lane & 31)] = W[(size_t)(k0 + kk) * ldw + n0 + (lane & 31)]; }
    asm volatile("s_waitcnt lgkmcnt(0)" ::: "memory");
    const int c = lane & 7;
#pragma unroll
    for (int j = 0; j < 4; ++j) { const int n = (lane >> 3) + 8 * j; const LAS float* s = scr + (8 * c) * 33 + n;
        u32x4 o; o.x = pk2(s[0 * 33], s[1 * 33]); o.y = pk2(s[2 * 33], s[3 * 33]); o.z = pk2(s[4 * 33], s[5 * 33]); o.w = pk2(s[6 * 33], s[7 * 33]);
        *(u32x4*)(WT + (size_t)(out_row0 + n) * ldo + k0 + 8 * c) = o; }
    asm volatile("s_waitcnt lgkmcnt(0)" ::: "memory");
}

__device__ __forceinline__ void absmax_item(const float* W, int ldw, int k0, int n0, unsigned* amax, int lane, int gu = -1) {
    f32x4 mx = (f32x4){0.f, 0.f, 0.f, 0.f};
#pragma unroll 8
    for (int i = 0; i < 64; ++i) { const f32x4 w = *(const f32x4*)(W + (size_t)(k0 + i) * ldw + n0 + 4 * lane);
        mx.x = fmaxf(mx.x, fabsf(w.x)); mx.y = fmaxf(mx.y, fabsf(w.y)); mx.z = fmaxf(mx.z, fabsf(w.z)); mx.w = fmaxf(mx.w, fabsf(w.w)); }
    const int c = n0 + 4 * lane; unsigned* a = amax + (gu < 0 ? c : ((c >> 7) * 256 + (c & 127) + 128 * gu));
    atomicMax(a, __float_as_uint(mx.x)); atomicMax(a + 1, __float_as_uint(mx.y)); atomicMax(a + 2, __float_as_uint(mx.z)); atomicMax(a + 3, __float_as_uint(mx.w));
}
__device__ __forceinline__ void quant_item(const float* W, int ldw, int k0, int n0, signed char* WQ, int ldo, int out_row0, const unsigned* amax, LAS float* scr, int lane) {
    f32x4 ld[8];
#pragma unroll
    for (int i = 0; i < 8; ++i) ld[i] = *(const f32x4*)(W + (size_t)(k0 + 8 * i + (lane >> 3)) * ldw + n0 + 4 * (lane & 7));
#pragma unroll
    for (int i = 0; i < 8; ++i) { LAS float* d = scr + (8 * i + (lane >> 3)) * 33 + 4 * (lane & 7); d[0] = ld[i].x; d[1] = ld[i].y; d[2] = ld[i].z; d[3] = ld[i].w; }
    asm volatile("s_waitcnt lgkmcnt(0)" ::: "memory");
    const int n = lane & 31, kh = lane >> 5;
    const float am = __uint_as_float(amax[out_row0 + n]); const float inv = am > 0.f ? 127.f / am : 0.f;
    const LAS float* sp = scr + (32 * kh) * 33 + n;
    unsigned w[8];
#pragma unroll
    for (int i = 0; i < 8; ++i) { const int q0 = __float2int_rn(sp[(4 * i) * 33] * inv), q1 = __float2int_rn(sp[(4 * i + 1) * 33] * inv), q2 = __float2int_rn(sp[(4 * i + 2) * 33] * inv), q3 = __float2int_rn(sp[(4 * i + 3) * 33] * inv);
        w[i] = (unsigned)(q0 & 0xff) | ((unsigned)(q1 & 0xff) << 8) | ((unsigned)(q2 & 0xff) << 16) | ((unsigned)(q3 & 0xff) << 24); }
    signed char* o = WQ + (size_t)(out_row0 + n) * ldo + k0 + 32 * kh;
    *(u32x4*)o = (u32x4){w[0], w[1], w[2], w[3]}; *(u32x4*)(o + 16) = (u32x4){w[4], w[5], w[6], w[7]};
    asm volatile("s_waitcnt lgkmcnt(0)" ::: "memory");
}
__device__ __forceinline__ void store_row_i8(signed char* row, float* scale, int lane, const f32x4 (&v)[4]) {
    float mx = 0.f;
#pragma unroll
    for (int j = 0; j < 4; ++j) mx = fmaxf(mx, fmaxf(fmaxf(fabsf(v[j].x), fabsf(v[j].y)), fmaxf(fabsf(v[j].z), fabsf(v[j].w))));
    mx = wave_max_dpp(mx);
    const float inv = mx > 0.f ? 127.f / mx : 0.f;
#pragma unroll
    for (int j = 0; j < 4; ++j) { const int q0 = __float2int_rn(v[j].x * inv), q1 = __float2int_rn(v[j].y * inv), q2 = __float2int_rn(v[j].z * inv), q3 = __float2int_rn(v[j].w * inv);
        *(unsigned*)(row + 4 * lane + 256 * j) = (unsigned)(q0 & 0xff) | ((unsigned)(q1 & 0xff) << 8) | ((unsigned)(q2 & 0xff) << 16) | ((unsigned)(q3 & 0xff) << 24); }
    if (lane == 0) *scale = mx * (1.f / 127.f);
}

__device__ __forceinline__ void quant_strip(Frame& F, const float* W, int ldw, int n0, signed char* WQ, int out_row0, unsigned* amax) {
    LAS float* T = (LAS float*)F.lds + F.wave * 4096; LAS float* cm = (LAS float*)(F.lds + 135168);
    const int lane = F.lane, w = F.wave, lr = lane >> 3, c4 = (lane & 7) * 4;
    f32x4 ld[16];
#pragma unroll
    for (int i = 0; i < 16; ++i) ld[i] = *(const f32x4*)(W + (size_t)(128 * w + 8 * i + lr) * ldw + n0 + c4);
    f32x4 mx = (f32x4){0.f, 0.f, 0.f, 0.f};
#pragma unroll
    for (int i = 0; i < 16; ++i) { const int kl = 8 * i + lr, sw = kl & 31; LAS float* d = T + kl * 32;
        d[(c4 + 0) ^ sw] = ld[i].x; d[(c4 + 1) ^ sw] = ld[i].y; d[(c4 + 2) ^ sw] = ld[i].z; d[(c4 + 3) ^ sw] = ld[i].w;
        mx.x = fmaxf(mx.x, fabsf(ld[i].x)); mx.y = fmaxf(mx.y, fabsf(ld[i].y)); mx.z = fmaxf(mx.z, fabsf(ld[i].z)); mx.w = fmaxf(mx.w, fabsf(ld[i].w)); }
#pragma unroll
    for (int o = 8; o < 64; o <<= 1) { mx.x = fmaxf(mx.x, __shfl_xor(mx.x, o)); mx.y = fmaxf(mx.y, __shfl_xor(mx.y, o)); mx.z = fmaxf(mx.z, __shfl_xor(mx.z, o)); mx.w = fmaxf(mx.w, __shfl_xor(mx.w, o)); }
    if (lane < 8) *(LAS f32x4*)(cm + w * 32 + c4) = mx;
    __syncthreads();
    const int n = lane & 31, h = lane >> 5;
    float am = cm[n];
#pragma unroll
    for (int ww = 1; ww < 8; ++ww) am = fmaxf(am, cm[ww * 32 + n]);
    const float inv = am > 0.f ? 127.f / am : 0.f;
    signed char* o = WQ + (size_t)(out_row0 + n) * 1024 + 128 * w + 64 * h;
#pragma unroll
    for (int i16 = 0; i16 < 4; ++i16) { unsigned wd[4];
#pragma unroll
        for (int i4 = 0; i4 < 4; ++i4) { const int kl = 64 * h + 16 * i16 + 4 * i4;
            const int q0 = __float2int_rn(T[(kl + 0) * 32 + (n ^ ((kl + 0) & 31))] * inv), q1 = __float2int_rn(T[(kl + 1) * 32 + (n ^ ((kl + 1) & 31))] * inv);
            const int q2 = __float2int_rn(T[(kl + 2) * 32 + (n ^ ((kl + 2) & 31))] * inv), q3 = __float2int_rn(T[(kl + 3) * 32 + (n ^ ((kl + 3) & 31))] * inv);
            wd[i4] = (unsigned)(q0 & 0xff) | ((unsigned)(q1 & 0xff) << 8) | ((unsigned)(q2 & 0xff) << 16) | ((unsigned)(q3 & 0xff) << 24); }
        *(u32x4*)(o + 16 * i16) = (u32x4){wd[0], wd[1], wd[2], wd[3]}; }
    if (w == 0 && lane < 32) amax[out_row0 + n] = __float_as_uint(am);
    __syncthreads();
}
__device__ __forceinline__ void quant_gu_strip(Frame& F, int le, int q) {
    const int up = q >> 4, n0 = (q & 15) * 32;
    quant_strip(F, F.in[up ? I_MU : I_MG] + (size_t)le * 1024 * 512, 512, n0, F.guq() + (size_t)le * 1024 * 1024, n0 + (n0 / 128) * 128 + up * 128, F.amax_gu() + le * 1024);
}
__device__ __forceinline__ void phase_prologue(Frame& F) {
    LAS float* sc = (LAS float*)F.lds;
    LAS float* red = sc + 9 * 1024;
    for (int i = F.tid; i < 9 * 1024; i += NTHREADS) { const float v = (i < 8192) ? F.in[I_C][i] : F.in[I_CCTX][i - 8192]; sc[i] = silu_f(v); }
    __syncthreads();
    for (int it = blockIdx.x; it < 192; it += F.G) {
        const int kc = it & 3, cb = (it >> 2) % 24, l = it / 96;
        const float* W = F.in[I_ADAW] + (size_t)l * 1024 * 6144 + cb * 256 + 4 * F.lane;
        const int k0 = kc * 256 + F.wave * 32;
        f32x4 acc[9];
#pragma unroll
        for (int r = 0; r < 9; ++r) acc[r] = (f32x4){0.f, 0.f, 0.f, 0.f};
#pragma unroll 8
        for (int i = 0; i < 32; ++i) { const int k = k0 + i; const f32x4 wv = *(const f32x4*)(W + (size_t)k * 6144);
#pragma unroll
            for (int r = 0; r < 9; ++r) acc[r] += sc[r * 1024 + k] * wv; }
#pragma unroll
        for (int r = 0; r < 9; ++r) *(LAS f32x4*)(red + (F.wave * 9 + r) * 256 + 4 * F.lane) = acc[r];
        __syncthreads();
        for (int idx = F.tid; idx < 2304; idx += NTHREADS) { const int r = idx >> 8, ci = idx & 255; float s = 0.f;
#pragma unroll
            for (int w = 0; w < 8; ++w) s += red[(w * 9 + r) * 256 + ci];
            F.modp()[(size_t)((kc * 2 + l) * 9 + r) * 6144 + cb * 256 + ci] = s; }
        __syncthreads();
    }
    __syncthreads();
    LAS float* scr = (LAS float*)(F.lds + F.wave * 16384);
    const int gw = blockIdx.x * NWAVES + F.wave, NGW = F.G * NWAVES;
    for (int i = blockIdx.x * NTHREADS + F.tid; i < 8 * 128 * 128; i += F.G * NTHREADS) F.wsbf()[i] = (bf16_t)f2bf(F.in[I_AWS][i]);
}
__device__ __forceinline__ void conv_dn_item(Frame& F, int le, int q, LAS float* scr) {
    const int kb = q / 32, nb = q % 32;
    transpose_item(F.in[I_MD] + (size_t)le * 512 * 1024, 1024, kb * 64, nb * 32, F.dn() + (size_t)le * 1024 * 512, 512, nb * 32, scr, F.lane);
}
__device__ __forceinline__ int filler_blocks(int seg) { return seg == 0 ? 48 : seg == 1 ? 512 : seg == 2 ? 200 : seg == 3 ? 312 : 0; }
__device__ __forceinline__ int filler_count(int seg) { return seg == 0 ? 3072 : seg == 1 ? 2560 : seg == 4 ? 4096 : 0; }
__device__ __forceinline__ void filler_block_item(Frame& F, int seg, int r) {
    if (seg == 0) quant_strip(F, F.in[I_BQKV], 1536, r * 32, F.wqkvq(), r * 32, F.amax_qkv());
    else if (seg == 1) quant_gu_strip(F, r >> 5, r & 31);
    else if (seg == 2) quant_gu_strip(F, 16 + (r >> 5), r & 31);
    else { const int q = r + 200; quant_gu_strip(F, 16 + (q >> 5), q & 31); }
}
__device__ __forceinline__ void filler_item(Frame& F, int seg, int r, LAS float* scr) {
    if (seg == 0) {
        if (r < 1024) { const int kb = r / 32, nb = r % 32; transpose_item(F.in[I_AWOUT], 1024, kb * 64, nb * 32, F.wout(), 2048, nb * 32, scr, F.lane); return; } r -= 1024;
        if (r < 512) { const int kb = r / 32, nb = r % 32; transpose_item(F.in[I_BWO], 1024, kb * 64, nb * 32, F.wo(), 1024, nb * 32, scr, F.lane); return; } r -= 512;
        conv_dn_item(F, r >> 8, r & 255, scr);
    } else if (seg == 1) { const int q = r + 1536; conv_dn_item(F, q >> 8, q & 255, scr);
    } else { conv_dn_item(F, 16 + (r >> 8), r & 255, scr); }
}
__device__ __forceinline__ void filler_static(Frame& F, int seg, int first_idle) {
    LAS float* scr = (LAS float*)(F.lds + F.wave * 16384);
    if (first_idle >= F.G || first_idle < 0) first_idle = 0;
    if ((int)blockIdx.x < first_idle) return;
    const int bi = (int)blockIdx.x - first_idle, nbi = F.G - first_idle, nbk = filler_blocks(seg);
    for (int r = bi; r < nbk; r += nbi) filler_block_item(F, seg, r);
    const int w = bi * NWAVES + F.wave, NW = nbi * NWAVES, n = filler_count(seg);
    for (int r = w; r < n; r += NW) filler_item(F, seg, r, scr);
}

__device__ __forceinline__ void load_row(const float* row, int lane, f32x4 (&v)[4]) {
#pragma unroll
    for (int j = 0; j < 4; ++j) v[j] = *(const f32x4*)(row + 4 * lane + 256 * j);
}
__device__ __forceinline__ void load_row_bf16(const bf16_t* row, int lane, f32x4 (&v)[4]) {
#pragma unroll
    for (int j = 0; j < 4; ++j) { const u32x2 w = *(const u32x2*)(row + 4 * lane + 256 * j);
        v[j] = (f32x4){__uint_as_float(w.x << 16), __uint_as_float(w.x & 0xffff0000u), __uint_as_float(w.y << 16), __uint_as_float(w.y & 0xffff0000u)}; }
}
__device__ __forceinline__ float row_sumsq(const f32x4 (&v)[4]) {
    float s = 0.f;
#pragma unroll
    for (int j = 0; j < 4; ++j) s += (v[j].x * v[j].x + v[j].y * v[j].y) + (v[j].z * v[j].z + v[j].w * v[j].w);
    return wave_sum_dpp(s);
}
__device__ __forceinline__ void store_row_bf16(bf16_t* row, int lane, const f32x4 (&v)[4]) {
#pragma unroll
    for (int j = 0; j < 4; ++j) { u32x2 o; o.x = pk2(v[j].x, v[j].y); o.y = pk2(v[j].z, v[j].w); *(u32x2*)(row + 4 * lane + 256 * j) = o; }
}
__device__ __forceinline__ void phase_norm1_l0(Frame& F) {
    for (int idx = blockIdx.x * NTHREADS + F.tid; idx < 2 * 9 * 6144; idx += F.G * NTHREADS) { const int l = idx / 55296, rem = idx % 55296; F.modf()[idx] = mod_from_partials(F, l, rem / 6144, rem % 6144); }
    for (int it = blockIdx.x; it < 128; it += F.G) quant_strip(F, F.in[I_AWIN], 4096, it * 32, F.winq(), it * 32, F.amax_in());
    LAS float* lmA = (LAS float*)F.lds; LAS float* lmB = lmA + 1024;
    const int per = (NT + F.G - 1) / F.G; const int r0 = blockIdx.x * per; int r1 = r0 + per; if (r1 > NT) r1 = NT;
    int lo = r0;
    while (lo < r1) {
        const int grp = lo / 2048; int hi = (grp + 1) * 2048; if (hi > r1) hi = r1;
        __syncthreads();
        for (int n = F.tid; n < 1024; n += NTHREADS) { lmA[n] = F.in[I_N1G][n] * (1.f + mod_from_partials(F, 0, grp, 1024 + n)); lmB[n] = mod_from_partials(F, 0, grp, n); }
        __syncthreads();
        int row = lo + F.wave; f32x4 vn[4];
        if (row < hi) load_row(xin_row(F, row), F.lane, vn);
        for (; row < hi; row += NWAVES) {
            f32x4 v[4];
#pragma unroll
            for (int j = 0; j < 4; ++j) v[j] = vn[j];
            if (row + NWAVES < hi) load_row(xin_row(F, row + NWAVES), F.lane, vn);
            const float rstd = rsqrtf(row_sumsq(v) * (1.f / D) + EPS);
#pragma unroll
            for (int j = 0; j < 4; ++j) { const int c = 4 * F.lane + 256 * j; v[j] = v[j] * rstd * *(const LAS f32x4*)(lmA + c) + *(const LAS f32x4*)(lmB + c); }
            store_row_i8(F.hq() + (size_t)row * D, F.hs() + row, F.lane, v);
        }
        lo = hi;
    }
}
template <int RMODE = 0> __device__ __forceinline__ void phase_norm2_route_t(Frame& F, int l, int nrows) {
    constexpr int HS_ = 1026;
    LAS float* Wr = (LAS float*)F.lds;
    LAS float* Ht = (LAS float*)(F.lds + 65536);
    LAS float* lmA = (LAS float*)(F.lds + 135168); LAS float* lmB = lmA + 1024;
    LAS float* Pp = lmB + 1024;
    LAS float* Lg = Pp + 2048;
    LAS unsigned* lcnt = (LAS unsigned*)(Lg + 96 * 16);
    LAS int* rec = (LAS int*)(lcnt + 32);
    unsigned* cnt = F.ctl() + CW_CNT + 16 * l;
    const int lane = F.lane, wave = F.wave;
    __syncthreads();
    f32x4 wreg[8];
#pragma unroll
    for (int i = 0; i < 8; ++i) wreg[i] = *(const f32x4*)(F.in[I_RW] + 4 * (F.tid + NTHREADS * i));
    bool wr_pending = true;
    if (F.tid < 32) lcnt[F.tid] = 0u;
    const int per = (nrows + F.G - 1) / F.G; const int r0 = blockIdx.x * per; int r1 = r0 + per; if (r1 > nrows) r1 = nrows;
    const bool remap = (nrows == NT) && (F.G == 256); const int bx = (int)blockIdx.x;
    auto phys = [&](int v) { return remap ? ((v - r0) < 64 ? 64 * bx + (v - r0) : NX + 8 * bx + (v - r0 - 64)) : v; };
    int lo = r0, pi = 0, prev_pb = -1, prev_hi = 0;
    auto reduce_prev = [&]() {
        if (prev_pb >= 0 && F.tid < 256 && prev_pb + (F.tid >> 4) < prev_hi) { const LAS float* pp = Pp; float s = 0.f;
#pragma unroll
            for (int w = 0; w < 8; ++w) s += pp[w * 256 + F.tid];
            Lg[(prev_pb - r0) * 16 + F.tid] = s; } };
    auto load_x1 = [&](int prow, bool cx, f32x4 (&v)[4]) {
        if (cx) { const float* c0 = F.in[I_CTX] + (size_t)(prow - NX) * D; const float* p0 = F.cxp() + (size_t)(prow - NX) * D; const float* p1 = p0 + (size_t)NCX * D; const float* g1 = F.modf() + (size_t)8 * 6144 + 2048;
#pragma unroll
            for (int j = 0; j < 4; ++j) { const int c = 4 * lane + 256 * j; v[j] = *(const f32x4*)(c0 + c) + *(const f32x4*)(g1 + c) * (*(const f32x4*)(p0 + c) + *(const f32x4*)(p1 + c)); } }
        else load_row_bf16(xb_row(F, prow), lane, v); };
    while (lo < r1) {
        const int grp = phys(lo) / 2048; int hi = remap ? (lo < r0 + 64 ? r0 + 64 : r1) : (grp + 1) * 2048; if (hi > r1) hi = r1;
        const bool ctxp = (l == 0) && (grp == 8);
        const float* mf = F.modf() + (size_t)(l * 9 + grp) * 6144;
        __syncthreads();
        for (int n = F.tid; n < 1024; n += NTHREADS) { lmA[n] = F.in[I_N2G][l * D + n] * (1.f + mf[4096 + n]); lmB[n] = mf[3072 + n]; }
        __syncthreads();
        f32x4 vn[2][4];
#pragma unroll
        for (int t = 0; t < 2; ++t) { const int r = lo + 8 * t + wave; load_x1(phys(r < hi ? r : lo), ctxp, vn[t]); }
        for (int pb = lo; pb < hi; pb += 16) {
#pragma unroll
            for (int t = 0; t < 2; ++t) { const int row = pb + 8 * t + wave; f32x4 v[4];
#pragma unroll
                for (int j = 0; j < 4; ++j) v[j] = vn[t][j];
                if (pb + 16 < hi) { const int r = row + 16; load_x1(phys(r < hi ? r : lo), ctxp, vn[t]); }
                if (ctxp && row < hi) store_row_bf16(xb_row(F, phys(row)), lane, v);
                const float rstd = rsqrtf(row_sumsq(v) * (1.f / D) + EPS);
#pragma unroll
                for (int j = 0; j < 4; ++j) { const int c = 4 * lane + 256 * j; v[j] = v[j] * rstd * *(const LAS f32x4*)(lmA + c) + *(const LAS f32x4*)(lmB + c);
                    *(LAS f32x2*)(Ht + (8 * t + wave) * HS_ + c) = (f32x2){v[j].x, v[j].y}; *(LAS f32x2*)(Ht + (8 * t + wave) * HS_ + c + 2) = (f32x2){v[j].z, v[j].w}; }
                if (RMODE != 3) { if (row < hi) { const int pr = phys(row); store_row_i8(F.hq() + (size_t)pr * D, F.hs() + pr, lane, v); } } }
            reduce_prev();
            if (wr_pending) { wr_pending = false;
#pragma unroll
                for (int i = 0; i < 8; ++i) *(LAS f32x4*)(Wr + 4 * (F.tid + NTHREADS * i)) = wreg[i]; }
            __syncthreads();
            if (RMODE != 1) { f32x4 acc = (f32x4){0.f, 0.f, 0.f, 0.f}; const int ar = lane & 15, ag = lane >> 4;
              const LAS float* ap = Ht + ar * HS_ + 128 * wave + 4 * ag; const LAS float* bp = Wr + (128 * wave + 4 * ag) * 16 + ar;
#pragma unroll
              for (int kk = 0; kk < 8; ++kk) { const f32x2 a01 = *(const LAS f32x2*)(ap + 16 * kk), a23 = *(const LAS f32x2*)(ap + 16 * kk + 2);
                  acc = __builtin_amdgcn_mfma_f32_16x16x4f32(a01.x, bp[(16 * kk + 0) * 16], acc, 0, 0, 0);
                  acc = __builtin_amdgcn_mfma_f32_16x16x4f32(a01.y, bp[(16 * kk + 1) * 16], acc, 0, 0, 0);
                  acc = __builtin_amdgcn_mfma_f32_16x16x4f32(a23.x, bp[(16 * kk + 2) * 16], acc, 0, 0, 0);
                  acc = __builtin_amdgcn_mfma_f32_16x16x4f32(a23.y, bp[(16 * kk + 3) * 16], acc, 0, 0, 0); }
              LAS float* pp = Pp;
#pragma unroll
              for (int j = 0; j < 4; ++j) pp[(wave * 16 + 4 * ag + j) * 16 + ar] = acc[j]; }
            __syncthreads();
            prev_pb = pb; prev_hi = hi; ++pi;
        }
        lo = hi;
    }
    reduce_prev();
    __syncthreads();
    if (F.tid < r1 - r0) {
        const int row = r0 + F.tid;
        float s[16], sb[16];
#pragma unroll
        for (int e4 = 0; e4 < 4; ++e4) { const f32x4 q = *(const LAS f32x4*)(Lg + F.tid * 16 + 4 * e4);
            s[4 * e4] = sigmoid_f(q.x); s[4 * e4 + 1] = sigmoid_f(q.y); s[4 * e4 + 2] = sigmoid_f(q.z); s[4 * e4 + 3] = sigmoid_f(q.w); }
#pragma unroll
        for (int e = 0; e < 16; ++e) sb[e] = s[e] + F.in[I_RB][e];
        float gs[4];
#pragma unroll
        for (int g = 0; g < 4; ++g) { const float a = sb[4 * g], b = sb[4 * g + 1], c = sb[4 * g + 2], d = sb[4 * g + 3];
            const float m1 = fmaxf(fmaxf(a, b), fmaxf(c, d));
            const float hi_ab = fmaxf(a, b), lo_ab = fminf(a, b), hi_cd = fmaxf(c, d), lo_cd = fminf(c, d);
            const float m2 = (hi_ab >= hi_cd) ? fmaxf(lo_ab, hi_cd) : fmaxf(lo_cd, hi_ab);
            gs[g] = m1 + m2; }
        int best = 0; float bv = gs[0];
#pragma unroll
        for (int g = 1; g < 4; ++g) if (gs[g] > bv) { bv = gs[g]; best = g; }
        float q[4], qs[4];
#pragma unroll
        for (int j = 0; j < 4; ++j) { q[j] = best == 0 ? sb[j] : best == 1 ? sb[4 + j] : best == 2 ? sb[8 + j] : sb[12 + j]; qs[j] = best == 0 ? s[j] : best == 1 ? s[4 + j] : best == 2 ? s[8 + j] : s[12 + j]; }
        int i1 = 0; float v1 = q[0];
#pragma unroll
        for (int j = 1; j < 4; ++j) if (q[j] > v1) { v1 = q[j]; i1 = j; }
        int i2 = -1; float v2 = -INFINITY;
#pragma unroll
        for (int j = 0; j < 4; ++j) if (j != i1 && q[j] > v2) { v2 = q[j]; i2 = j; }
        const float w1 = i1 == 0 ? qs[0] : i1 == 1 ? qs[1] : i1 == 2 ? qs[2] : qs[3];
        const float w2 = i2 == 0 ? qs[0] : i2 == 1 ? qs[1] : i2 == 2 ? qs[2] : qs[3];
        const float inv = 1.f / (w1 + w2);
        const int e0 = best * 4 + i1, e1 = best * 4 + i2;
        const unsigned lp0 = atomicAdd((unsigned*)(lcnt + e0), 1u), lp1 = atomicAdd((unsigned*)(lcnt + e1), 1u);
        LAS int* rc = rec + F.tid * 6;
        rc[0] = e0; rc[1] = e1; rc[2] = (int)lp0; rc[3] = (int)lp1; rc[4] = __float_as_int(w1 * inv); rc[5] = __float_as_int(w2 * inv);
        (void)row;
    }
    __syncthreads();
    if (F.tid < 16) { const unsigned n = lcnt[F.tid]; lcnt[16 + F.tid] = n ? atomicAdd(cnt + F.tid, n) : 0u; }
    __syncthreads();
    for (int rl = F.tid; rl < r1 - r0; rl += NTHREADS) {
        const LAS int* rc = rec + rl * 6; const int row = phys(r0 + rl), e0 = rc[0], e1 = rc[1];
        const int p0 = (int)lcnt[16 + e0] + rc[2], p1 = (int)lcnt[16 + e1] + rc[3];
        F.list()[(size_t)e0 * NT + p0] = row; F.list()[(size_t)e1 * NT + p1] = row;
        F.toke()[2 * row] = e0; F.toke()[2 * row + 1] = e1; F.tokp()[2 * row] = p0; F.tokp()[2 * row + 1] = p1;
        F.tokw()[2 * row] = __int_as_float(rc[4]); F.tokw()[2 * row + 1] = __int_as_float(rc[5]);
    }
}
__device__ __forceinline__ void phase_norm2_route(Frame& F, int l, int nrows) { phase_norm2_route_t<0>(F, l, nrows); }
struct YRows { u32x2 a[4], b[4]; };
__device__ __forceinline__ void load_y(const Frame& F, const LAS int* ti, int lane, YRows& y) {
    const bf16_t* y0 = F.y() + (size_t)ti[0] * D; const bf16_t* y1 = F.y() + (size_t)ti[1] * D;
#pragma unroll
    for (int j = 0; j < 4; ++j) { y.a[j] = *(const u32x2*)(y0 + 4 * lane + 256 * j); y.b[j] = *(const u32x2*)(y1 + 4 * lane + 256 * j); }
}
template <bool FINAL> __device__ __forceinline__ void phase_combine(Frame& F, int l, int nrows) {
    const unsigned* cnt = F.ctl() + CW_CNT + 16 * l;
    LAS float* lmA = (LAS float*)F.lds; LAS float* lmB = lmA + 1024; LAS float* lmG = lmB + 1024;
    LAS int* eoff = (LAS int*)(lmG + 1024); LAS int* tinf = eoff + 16;
    const int per = (nrows + F.G - 1) / F.G; const int r0 = blockIdx.x * per; int r1 = r0 + per; if (r1 > nrows) r1 = nrows;
    const bool remap = (nrows == NT) && (F.G == 256); const int bx = (int)blockIdx.x;
    auto phys = [&](int v) { return remap ? ((v - r0) < 64 ? 64 * bx + (v - r0) : NX + 8 * bx + (v - r0 - 64)) : v; };
    __syncthreads();
    if (F.tid == 0) { int o = 0; for (int e = 0; e < 16; ++e) { eoff[e] = o; o += ((int)cnt[e] + 255) & ~255; } }
    __syncthreads();
    for (int rl = F.tid; rl < r1 - r0; rl += NTHREADS) { const int row = phys(r0 + rl);
        tinf[rl * 4] = eoff[F.toke()[2 * row]] + F.tokp()[2 * row]; tinf[rl * 4 + 1] = eoff[F.toke()[2 * row + 1]] + F.tokp()[2 * row + 1];
        tinf[rl * 4 + 2] = __float_as_int(F.tokw()[2 * row]); tinf[rl * 4 + 3] = __float_as_int(F.tokw()[2 * row + 1]); }
    int lo = r0;
    while (lo < r1) {
        const int grp = phys(lo) / 2048; int hi = remap ? (lo < r0 + 64 ? r0 + 64 : r1) : (grp + 1) * 2048; if (hi > r1) hi = r1;
        const float* mf = F.modf() + (size_t)(l * 9 + grp) * 6144;
        __syncthreads();
        for (int n = F.tid; n < 1024; n += NTHREADS) { lmG[n] = mf[5120 + n];
            if (FINAL) { lmA[n] = F.in[I_FG][n]; } else { const float* mn = F.modf() + (size_t)((l + 1) * 9 + grp) * 6144; lmA[n] = F.in[I_N1G][(l + 1) * D + n] * (1.f + mn[1024 + n]); lmB[n] = mn[n]; } }
        __syncthreads();
        int row = lo + F.wave; f32x4 vn[4]; YRows yn;
        if (row < hi) { load_row_bf16(xb_row(F, phys(row)), F.lane, vn); load_y(F, tinf + (row - r0) * 4, F.lane, yn); }
        for (; row < hi; row += NWAVES) {
            f32x4 v[4]; YRows y = yn;
#pragma unroll
            for (int j = 0; j < 4; ++j) v[j] = vn[j];
            const float w0 = __int_as_float(tinf[(row - r0) * 4 + 2]), w1 = __int_as_float(tinf[(row - r0) * 4 + 3]);
            if (row + NWAVES < hi) { load_row_bf16(xb_row(F, phys(row + NWAVES)), F.lane, vn); load_y(F, tinf + (row + NWAVES - r0) * 4, F.lane, yn); }
#pragma unroll
            for (int j = 0; j < 4; ++j) { const int c = 4 * F.lane + 256 * j; const f32x4 g2 = *(const LAS f32x4*)(lmG + c); const u32x2 a = y.a[j], b = y.b[j];
                f32x4 m; m.x = w0 * __uint_as_float(a.x << 16) + w1 * __uint_as_float(b.x << 16); m.y = w0 * __uint_as_float(a.x & 0xffff0000u) + w1 * __uint_as_float(b.x & 0xffff0000u);
                m.z = w0 * __uint_as_float(a.y << 16) + w1 * __uint_as_float(b.y << 16); m.w = w0 * __uint_as_float(a.y & 0xffff0000u) + w1 * __uint_as_float(b.y & 0xffff0000u);
                v[j] = v[j] + g2 * m; }
            const float rstd = rsqrtf(row_sumsq(v) * (1.f / D) + EPS);
            if (FINAL) {
#pragma unroll
                for (int j = 0; j < 4; ++j) { const int c = 4 * F.lane + 256 * j; *(f32x4*)(F.out + (size_t)phys(row) * D + c) = v[j] * rstd * *(const LAS f32x4*)(lmA + c); }
            } else {
                store_row_bf16(xb_row(F, phys(row)), F.lane, v);
#pragma unroll
                for (int j = 0; j < 4; ++j) { const int c = 4 * F.lane + 256 * j; v[j] = v[j] * rstd * *(const LAS f32x4*)(lmA + c) + *(const LAS f32x4*)(lmB + c); }
                { const int pr = phys(row); store_row_i8(F.hq() + (size_t)pr * D, F.hs() + pr, F.lane, v); }
            }
        }
        lo = hi;
    }
}

template <int NBM, class AR, class BR0, class BR1, class EPI>
__device__ __forceinline__ void ngemm_unit(LAS unsigned char* lds, int tid, AR arow, BR0 brow0, BR1 brow1, int K, EPI epi) {
    const int lane = tid & 63, wave = tid >> 6, wr = wave >> 2, wc = wave & 3, fr = lane & 15, fq = lane >> 4;
    LAS bf16_t* As = (LAS bf16_t*)lds; LAS bf16_t* Bs0 = As + 128 * 40; LAS bf16_t* Bs1 = Bs0 + 128 * 40;
    const int lr = tid >> 2, lc = (tid & 3) * 8;
    const bf16_t* ap = arow(lr) + lc; const bf16_t* bp0 = brow0(lr) + lc; const bf16_t* bp1 = brow1(lr) + lc;
    f32x4 acc0[4][2], acc1[4][2];
#pragma unroll
    for (int m = 0; m < 4; ++m)
#pragma unroll
        for (int n = 0; n < 2; ++n) { acc0[m][n] = (f32x4){0.f, 0.f, 0.f, 0.f}; acc1[m][n] = (f32x4){0.f, 0.f, 0.f, 0.f}; }
    for (int k0 = 0; k0 < K; k0 += 32) {
        const u32x4 va = *(const u32x4*)(ap + k0), vb0 = *(const u32x4*)(bp0 + k0); u32x4 vb1 = va; if (NBM > 1) vb1 = *(const u32x4*)(bp1 + k0);
        __syncthreads();
        *(LAS u32x4*)(As + lr * 40 + lc) = va; *(LAS u32x4*)(Bs0 + lr * 40 + lc) = vb0; if (NBM > 1) *(LAS u32x4*)(Bs1 + lr * 40 + lc) = vb1;
        __syncthreads();
        bf16x8 a[4], b0[2], b1[2];
#pragma unroll
        for (int m = 0; m < 4; ++m) a[m] = *(const LAS bf16x8*)(As + (wr * 64 + m * 16 + fr) * 40 + fq * 8);
#pragma unroll
        for (int n = 0; n < 2; ++n) { b0[n] = *(const LAS bf16x8*)(Bs0 + (wc * 32 + n * 16 + fr) * 40 + fq * 8); if (NBM > 1) b1[n] = *(const LAS bf16x8*)(Bs1 + (wc * 32 + n * 16 + fr) * 40 + fq * 8); else b1[n] = b0[n]; }
#pragma unroll
        for (int m = 0; m < 4; ++m)
#pragma unroll
            for (int n = 0; n < 2; ++n) { acc0[m][n] = __builtin_amdgcn_mfma_f32_16x16x32_bf16(a[m], b0[n], acc0[m][n], 0, 0, 0);
                if (NBM > 1) acc1[m][n] = __builtin_amdgcn_mfma_f32_16x16x32_bf16(a[m], b1[n], acc1[m][n], 0, 0, 0); }
    }
#pragma unroll
    for (int m = 0; m < 4; ++m)
#pragma unroll
        for (int n = 0; n < 2; ++n)
#pragma unroll
            for (int j = 0; j < 4; ++j) epi(wr * 64 + m * 16 + fq * 4 + j, wc * 32 + n * 16 + fr, acc0[m][n][j], acc1[m][n][j]);
    __syncthreads();
}

__device__ __forceinline__ void phase_gemm1_naive(Frame& F) {
    for (int u = blockIdx.x; u < 144 * 32; u += F.G) {
        const int mt = u / 32, nt = u % 32;
        const bf16_t* A = F.h() + (size_t)mt * 128 * D; const bf16_t* B = F.win() + (size_t)nt * 128 * D;
        bf16_t* U = F.u(); bf16_t* VT = F.vt();
        ngemm_unit<1>(F.lds, F.tid, [=](int r) { return A + (size_t)r * D; }, [=](int n) { return B + (size_t)n * D; }, [=](int n) { return B + (size_t)n * D; }, D,
            [=](int r, int c, float v, float) { const int row = mt * 128 + r, col = nt * 128 + c; const float g = gelu_tanh(v);
                if (col < AW) U[(size_t)row * AW + col] = (bf16_t)f2bf(g); else VT[(size_t)(col - AW) * NT + row] = (bf16_t)f2bf(g); });
    }
}
__device__ __forceinline__ void phase_vsq_naive(Frame& F) {
    for (int tok = blockIdx.x * NTHREADS + F.tid; tok < NT; tok += F.G * NTHREADS) {
        float s = 0.f;
        for (int ch = 0; ch < AW; ++ch) { const float v = bf2f(F.vt()[(size_t)ch * NT + tok]); s += v * v; }
        F.vsq()[(size_t)tok * 32] = s;
        for (int j = 1; j < 32; ++j) F.vsq()[(size_t)tok * 32 + j] = 0.f;
    }
}
__device__ __forceinline__ void phase_vnorm_naive(Frame& F) {
    for (int tok = blockIdx.x * NTHREADS + F.tid; tok < NT; tok += F.G * NTHREADS) {
        float s = 0.f;
        for (int j = 0; j < 32; ++j) s += F.vsq()[(size_t)tok * 32 + j];
        const float rstd = rsqrtf(s * (1.f / AW) + EPS);
        for (int ch = 0; ch < AW; ++ch) { const size_t i = (size_t)ch * NT + tok; F.vt()[i] = (bf16_t)f2bf(bf2f(F.vt()[i]) * rstd * F.in[I_AGV][ch]); }
    }
}
__device__ __forceinline__ void phase_sgu_naive(Frame& F) {
    for (int u = blockIdx.x; u < 144 * 16; u += F.G) {
        const int c = u / 16, g = (u % 16) >> 1, nh = u & 1;
        const bf16_t* A = F.wsbf() + (size_t)g * 128 * 128; const bf16_t* B = F.vt() + (size_t)(g * 256 + nh * 128) * NT + (size_t)c * 128;
        bf16_t* U = F.u(); const float* bs = F.in[I_ABS] + g * 128;
        ngemm_unit<1>(F.lds, F.tid, [=](int r) { return A + (size_t)r * 128; }, [=](int n) { return B + (size_t)n * NT; }, [=](int n) { return B + (size_t)n * NT; }, 128,
            [=](int r, int ci, float v, float) { const size_t i = (size_t)(c * 128 + r) * AW + g * 256 + nh * 128 + ci; U[i] = (bf16_t)f2bf(bf2f(U[i]) * (v + bs[r])); });
    }
}
__device__ __forceinline__ void phase_gemm2_naive(Frame& F) {
    for (int u = blockIdx.x; u < 144 * 8; u += F.G) {
        const int mt = u / 8, nt = u % 8;
        const bf16_t* A = F.u() + (size_t)mt * 128 * U_LD; const bf16_t* B = F.wout() + (size_t)nt * 128 * AW;
        bf16_t* xbh = F.xbh(); const float* x0 = F.in[I_X]; const float* c0 = F.in[I_CTX]; const float* mf = F.modf();
        ngemm_unit<1>(F.lds, F.tid, [=](int r) { return A + (size_t)r * U_LD; }, [=](int n) { return B + (size_t)n * AW; }, [=](int n) { return B + (size_t)n * AW; }, AW,
            [=](int r, int c, float v, float) { const int row = mt * 128 + r, col = nt * 128 + c; const float g1 = mf[(size_t)(row / 2048) * 6144 + 2048 + col];
                const float xin = row < NX ? x0[(size_t)row * D + col] : c0[(size_t)(row - NX) * D + col]; xbh[(size_t)row * D + col] = (bf16_t)f2bf(xin + g1 * v); });
    }
}
__device__ __forceinline__ void phase_gateup_naive(Frame& F, int l) {
    const unsigned* cnt = F.ctl() + CW_CNT + 16 * l;
    int ubase = 0, off = 0;
    for (int e = 0; e < NE; ++e) {
        const int n = (int)cnt[e], mt128 = ((n + 255) >> 8) * 2, nu = mt128 * 4;
        int u = blockIdx.x; if (u < ubase) u += ((ubase - u + F.G - 1) / F.G) * F.G;
        for (; u < ubase + nu; u += F.G) {
            const int lu = u - ubase, mt = lu >> 2, pn = lu & 3;
            const int* lst = F.list() + (size_t)e * NT; const bf16_t* H = F.h(); const bf16_t* B = F.gu() + (size_t)(l * 16 + e) * 1024 * 1024 + (size_t)pn * 256 * 1024;
            bf16_t* HID = F.hid() + (size_t)(off + mt * 128) * DE + pn * 128;
            ngemm_unit<2>(F.lds, F.tid, [=](int r) { const int sr = mt * 128 + r; const int tok = lst[sr < n ? sr : 0]; return H + (size_t)tok * D; },
                [=](int c) { return B + (size_t)c * 1024; }, [=](int c) { return B + (size_t)(128 + c) * 1024; }, D,
                [=](int r, int c, float g, float up) { HID[(size_t)r * DE + c] = (bf16_t)f2bf(silu_f(g) * up); });
        }
        ubase += nu; off += (n + 255) & ~255;
    }
}
__device__ __forceinline__ void phase_down_naive(Frame& F, int l) {
    const unsigned* cnt = F.ctl() + CW_CNT + 16 * l;
    int ubase = 0, off = 0;
    for (int e = 0; e < NE; ++e) {
        const int n = (int)cnt[e], mt128 = ((n + 255) >> 8) * 2, nu = mt128 * 8;
        int u = blockIdx.x; if (u < ubase) u += ((ubase - u + F.G - 1) / F.G) * F.G;
        for (; u < ubase + nu; u += F.G) {
            const int lu = u - ubase, mt = lu >> 3, nt = lu & 7;
            const bf16_t* A = F.hid() + (size_t)(off + mt * 128) * DE; const bf16_t* B = F.dn() + (size_t)(l * 16 + e) * 1024 * 512 + (size_t)nt * 128 * 512;
            bf16_t* Y = F.y() + (size_t)(off + mt * 128) * D + nt * 128;
            ngemm_unit<1>(F.lds, F.tid, [=](int r) { return A + (size_t)r * DE; }, [=](int c) { return B + (size_t)c * DE; }, [=](int c) { return B + (size_t)c * DE; }, DE,
                [=](int r, int c, float v, float) { Y[(size_t)r * D + c] = (bf16_t)f2bf(v); });
        }
        ubase += nu; off += (n + 255) & ~255;
    }
}
__device__ __forceinline__ void phase_qkv_naive(Frame& F) {
    for (int u = blockIdx.x; u < 144 * 12; u += F.G) {
        const int mt = u / 12, nt = u % 12;
        if (mt >= 128 && nt < 8) continue;
        const bf16_t* A = F.h() + (size_t)mt * 128 * D; const bf16_t* B = F.wqkv() + (size_t)nt * 128 * D;
        bf16_t *Q = F.q(), *K = F.k(), *V = F.v();
        ngemm_unit<1>(F.lds, F.tid, [=](int r) { return A + (size_t)r * D; }, [=](int n) { return B + (size_t)n * D; }, [=](int n) { return B + (size_t)n * D; }, D,
            [=](int r, int c, float v, float) { const int row = mt * 128 + r, col = nt * 128 + c;
                if (col < 1024) Q[(size_t)row * 1024 + col] = (bf16_t)f2bf(v); else if (col < 1280) K[(size_t)row * KVD + col - 1024] = (bf16_t)f2bf(v); else V[(size_t)row * KVD + col - 1280] = (bf16_t)f2bf(v); });
    }
}
__device__ __forceinline__ void phase_rope_naive(Frame& F) {
    for (int idx = blockIdx.x * NTHREADS + F.tid; idx < NX * 640; idx += F.G * NTHREADS) {
        const int f = idx & 15, a = (idx >> 4) & 1, hs = (idx >> 5) % 20, row = idx / 640;
        bf16_t* p = hs < 16 ? F.q() + (size_t)row * 1024 + hs * 64 : F.k() + (size_t)row * KVD + (hs - 16) * 64;
        const float x1 = bf2f(p[a * 32 + f]), x2 = bf2f(p[a * 32 + 16 + f]);
        const int pos = row & 2047; const float pp = (float)(a ? (pos & 63) : (pos >> 6));
        const float inv = exp2f(-(float)f * (13.287712379549449f / 16.f));
        float rev = pp * inv * 0.15915494309189535f; rev -= floorf(rev);
        const float sn = __builtin_amdgcn_sinf(rev), cs = __builtin_amdgcn_cosf(rev);
        const float sc = hs < 16 ? QSCALE : 1.f;
        p[a * 32 + f] = (bf16_t)f2bf((x1 * cs - x2 * sn) * sc); p[a * 32 + 16 + f] = (bf16_t)f2bf((x2 * cs + x1 * sn) * sc);
    }
}
__device__ __forceinline__ void phase_attn_naive(Frame& F) {
    for (int idx = blockIdx.x * NTHREADS + F.tid; idx < NX * 16; idx += F.G * NTHREADS) {
        const int pos = idx & 2047, head = (idx >> 11) & 15, b = idx >> 15, hk = head >> 2;
        const int row = b * SEQ + pos;
        float q[64], o[64];
        { const bf16_t* qp = F.q() + (size_t)row * 1024 + head * 64;
#pragma unroll
          for (int d8 = 0; d8 < 8; ++d8) { const u32x4 w = *(const u32x4*)(qp + 8 * d8);
#pragma unroll
              for (int i = 0; i < 4; ++i) { q[8 * d8 + 2 * i] = __uint_as_float(w[i] << 16); q[8 * d8 + 2 * i + 1] = __uint_as_float(w[i] & 0xffff0000u); } } }
#pragma unroll
        for (int d = 0; d < 64; ++d) o[d] = 0.f;
        float m = F.in[I_BSINK][head] * LOG2E, lsum = 1.f;
        const int w_lo = pos - 128 < 0 ? 0 : pos - 128, w_hi = pos + 128 > SEQ - 1 ? SEQ - 1 : pos + 128;
        const int nwin = w_hi - w_lo + 1;
        for (int j = 0; j < CTXL + nwin; ++j) {
            const int krow = j < CTXL ? NX + b * CTXL + j : b * SEQ + w_lo + (j - CTXL);
            const bf16_t* kp = F.k() + (size_t)krow * KVD + hk * 64; const bf16_t* vp = F.v() + (size_t)krow * KVD + hk * 64;
            float s = 0.f;
#pragma unroll
            for (int d8 = 0; d8 < 8; ++d8) { const u32x4 w = *(const u32x4*)(kp + 8 * d8);
#pragma unroll
                for (int i = 0; i < 4; ++i) { s += q[8 * d8 + 2 * i] * __uint_as_float(w[i] << 16); s += q[8 * d8 + 2 * i + 1] * __uint_as_float(w[i] & 0xffff0000u); } }
            const float mn = fmaxf(m, s), f = exp2f(m - mn), pj = exp2f(s - mn);
            lsum = lsum * f + pj; m = mn;
#pragma unroll
            for (int d8 = 0; d8 < 8; ++d8) { const u32x4 w = *(const u32x4*)(vp + 8 * d8);
#pragma unroll
                for (int i = 0; i < 4; ++i) { o[8 * d8 + 2 * i] = o[8 * d8 + 2 * i] * f + pj * __uint_as_float(w[i] << 16); o[8 * d8 + 2 * i + 1] = o[8 * d8 + 2 * i + 1] * f + pj * __uint_as_float(w[i] & 0xffff0000u); } }
        }
        const float il = 1.f / lsum;
        bf16_t* op = F.o() + (size_t)row * 1024 + head * 64;
#pragma unroll
        for (int d8 = 0; d8 < 8; ++d8) { u32x4 w;
#pragma unroll
            for (int i = 0; i < 4; ++i) w[i] = pk2(o[8 * d8 + 2 * i] * il, o[8 * d8 + 2 * i + 1] * il);
            *(u32x4*)(op + 8 * d8) = w; }
    }
}
__device__ __forceinline__ void phase_wo_naive(Frame& F) {
    for (int u = blockIdx.x; u < 128 * 8; u += F.G) {
        const int mt = u / 8, nt = u % 8;
        const bf16_t* A = F.o() + (size_t)mt * 128 * D; const bf16_t* B = F.wo() + (size_t)nt * 128 * D;
        bf16_t* out = F.xbh(); const float* mf = F.modf() + (size_t)9 * 6144;
        ngemm_unit<1>(F.lds, F.tid, [=](int r) { return A + (size_t)r * D; }, [=](int n) { return B + (size_t)n * D; }, [=](int n) { return B + (size_t)n * D; }, D,
            [=](int r, int c, float v, float) { const int row = mt * 128 + r, col = nt * 128 + c; const float g1 = mf[(size_t)(row / 2048) * 6144 + 2048 + col];
                out[(size_t)row * D + col] = (bf16_t)f2bf(bf2f(out[(size_t)row * D + col]) + g1 * v); });
    }
}

namespace pg8 {
constexpr int BM = 256, BK = 64, HALF = 128, HTB = HALF * BK * 2, STAGE_BYTES = 8 * HTB;
__device__ __forceinline__ int lds_byte(int r, int c) { const int st = (r >> 4) * 2 + (c >> 5), rr = r & 15, cc = c & 31, ob = rr * 64 + cc * 2; return st * 1024 + (ob ^ (((ob >> 9) & 1) << 5)); }
__device__ __forceinline__ void stage_rc(int b, int& R, int& C) { const int st = b / 1024, sb = b % 1024, swz = sb ^ (((sb >> 9) & 1) << 5); R = (st >> 1) * 16 + swz / 64; C = (st & 1) * 32 + (swz % 64) / 2; }
__device__ __forceinline__ int perm32(int rho) { const int n = rho >> 4, i = rho & 15; return 8 * (i >> 2) + 4 * n + (i & 3); }

struct Unit { int pm, pn, e, aux, lbase, sel, koff; };
struct Gemm { const void* A; const void* Bt; int lda, ldb, K; size_t bstride; };
typedef int v4i32 __attribute__((ext_vector_type(4)));

template <class Epi, class Sched, bool GATHER, bool SWAPMODE, bool ALIGN_EPI, bool I8 = false>
__device__ __forceinline__ void gemm_phase(LAS unsigned char* lds, const Gemm g, const Sched& S, const Epi& E, LAS int* idxtab) {
    const int tid = threadIdx.x, wid = __builtin_amdgcn_readfirstlane(tid >> 6), lane = tid & 63, wr = wid >> 2, wc = wid & 3, fr = lane & 15, fq = lane >> 4;
    const int nt = g.K / (BK * 2);
    unsigned voffA[2], voffB[2]; int RA[2], CA2[2];
#pragma unroll
    for (int i = 0; i < 2; ++i) { int R, C; stage_rc(tid * 16 + i * 8192, R, C); const int Rb = Epi::PERM ? ((R & ~31) + perm32(R & 31)) : R;
        voffA[i] = (unsigned)(R * g.lda + C * 2); voffB[i] = (unsigned)(Rb * g.ldb + C * 2); RA[i] = R; CA2[i] = C * 2; }
    const size_t kstep = (size_t)(BK * 2);
    const size_t hstepA = (size_t)HALF * g.lda, hstepB = (size_t)HALF * g.ldb, tstepA = 2 * hstepA, tstepB = 2 * hstepB;
    const unsigned ldsw = (unsigned)wid * 1024u;
    const int aoff = lds_byte(wr * 64 + fr, fq * 8), boff = lds_byte(wc * 32 + fr, fq * 8);
#define PG8_SA(b, h) (((b) * 2 + (h)) * HTB)
#define PG8_SB(b, h) ((4 + (b) * 2 + (h)) * HTB)
#define PG8_STG(bufoff, P0, P1) do { \
        __builtin_amdgcn_global_load_lds((const unsigned*)(P0), (LAS unsigned*)(lds + (bufoff) + ldsw), 16, 0, 0); \
        __builtin_amdgcn_global_load_lds((const unsigned*)(P1), (LAS unsigned*)(lds + (bufoff) + ldsw + 8192), 16, 0, 0); } while (0)
#define PG8_STAGE_B(bufoff, base) PG8_STG(bufoff, (base) + voffB[0], (base) + voffB[1])
#define PG8_STAGE_A(bufoff, base, h, GS) do { if constexpr (GATHER) { PG8_STG(bufoff, (base) + GS[h][0], (base) + GS[h][1]); } \
        else { PG8_STG(bufoff, (base) + (h) * hstepA + voffA[0], (base) + (h) * hstepA + voffA[1]); } } while (0)
#define PG8_LDA(dst, b, h) do { _Pragma("unroll") for (int m = 0; m < 4; ++m) _Pragma("unroll") for (int k = 0; k < 2; ++k) dst[m][k] = *(const LAS bf16x8*)(lds + PG8_SA(b, h) + aoff + m * 2048 + k * 1024); } while (0)
#define PG8_LDB(dst, b, h) do { _Pragma("unroll") for (int n = 0; n < 2; ++n) _Pragma("unroll") for (int k = 0; k < 2; ++k) dst[n][k] = *(const LAS bf16x8*)(lds + PG8_SB(b, h) + boff + n * 2048 + k * 1024); } while (0)
#define PG8_MMA(ai, bj, At, Bt_) do { __builtin_amdgcn_s_setprio(1); \
        if (SWAPMODE && swapc) { _Pragma("unroll") for (int m = 0; m < 4; ++m) _Pragma("unroll") for (int n = 0; n < 2; ++n) _Pragma("unroll") for (int k = 0; k < 2; ++k) \
            acc[ai][bj][m][n] = __builtin_amdgcn_mfma_f32_16x16x32_bf16(At[m][k], Bt_[n][k], acc[ai][bj][m][n], 0, 0, 0); } \
        else if constexpr (I8) { _Pragma("unroll") for (int m = 0; m < 4; ++m) _Pragma("unroll") for (int n = 0; n < 2; ++n) _Pragma("unroll") for (int k = 0; k < 2; ++k) \
            acc[ai][bj][m][n] = __builtin_bit_cast(f32x4, __builtin_amdgcn_mfma_i32_16x16x64_i8(__builtin_bit_cast(v4i32, Bt_[n][k]), __builtin_bit_cast(v4i32, At[m][k]), __builtin_bit_cast(v4i32, acc[ai][bj][m][n]), 0, 0, 0)); } \
        else { _Pragma("unroll") for (int m = 0; m < 4; ++m) _Pragma("unroll") for (int n = 0; n < 2; ++n) _Pragma("unroll") for (int k = 0; k < 2; ++k) \
            acc[ai][bj][m][n] = __builtin_amdgcn_mfma_f32_16x16x32_bf16(Bt_[n][k], At[m][k], acc[ai][bj][m][n], 0, 0, 0); } \
        __builtin_amdgcn_s_setprio(0); } while (0)
#define PG8_WAIT_V(n) asm volatile("s_waitcnt vmcnt(" #n ")" ::: "memory")
#define PG8_WAIT_L(n) asm volatile("s_waitcnt lgkmcnt(" #n ")" ::: "memory")
#define PG8_BAR __builtin_amdgcn_s_barrier()
#define PG8_SCHED __builtin_amdgcn_sched_barrier(0)
    Unit cur, nxt; int ui = 0;
    if (!S.next(0, cur)) return;
    f32x4 acc[2][2][4][2];
#pragma unroll
    for (int a = 0; a < 2; ++a)
#pragma unroll
        for (int b = 0; b < 2; ++b)
#pragma unroll
            for (int m = 0; m < 4; ++m)
#pragma unroll
                for (int n = 0; n < 2; ++n) acc[a][b][m][n] = (f32x4){0.f, 0.f, 0.f, 0.f};
    bf16x8 At[4][2], B0[2][2], B1[2][2];
    const char* gA = (const char*)g.A; const char* gB = (const char*)g.Bt;
    const char* cA = GATHER ? gA : gA + (size_t)cur.pm * tstepA + cur.koff;
    const char* cB = gB + (size_t)cur.e * g.bstride + (size_t)cur.pn * tstepB + cur.koff;
    bool swapc = SWAPMODE ? (cur.aux != 0) : false;
    unsigned gc[2][2], gn[2][2], g2[2][2];
    if constexpr (GATHER) {
#pragma unroll
        for (int h = 0; h < 2; ++h)
#pragma unroll
            for (int i = 0; i < 2; ++i) { gc[h][i] = (unsigned)(*S.idx_ptr(cur, h * HALF + RA[i])) * (unsigned)g.lda + (unsigned)CA2[i]; gn[h][i] = gc[h][i]; g2[h][i] = gc[h][i]; }
        if (wid < 4) idxtab[wid * 64 + lane] = *S.idx_ptr(cur, wid * 64 + lane);
    } else {
#pragma unroll
        for (int h = 0; h < 2; ++h)
#pragma unroll
            for (int i = 0; i < 2; ++i) { gc[h][i] = 0u; gn[h][i] = 0u; g2[h][i] = 0u; }
    }
    PG8_STAGE_B(PG8_SB(0, 0), cB); PG8_STAGE_B(PG8_SB(0, 1), cB + hstepB); PG8_STAGE_A(PG8_SA(0, 0), cA, 0, gc); PG8_STAGE_A(PG8_SA(0, 1), cA, 1, gc);
    if (wr == 1) PG8_BAR;
    PG8_WAIT_V(2); PG8_BAR;
    PG8_STAGE_B(PG8_SB(1, 0), cB + kstep); PG8_STAGE_A(PG8_SA(1, 0), cA + kstep, 0, gc); PG8_STAGE_B(PG8_SB(1, 1), cB + hstepB + kstep);
    PG8_WAIT_V(6); PG8_BAR;
    for (;;) {
        const bool has_next = S.next(ui + 1, nxt);
        const char* nA = GATHER ? gA : (has_next ? gA + (size_t)nxt.pm * tstepA + nxt.koff : cA);
        const char* nB = has_next ? gB + (size_t)nxt.e * g.bstride + (size_t)nxt.pn * tstepB + nxt.koff : cB;
        if constexpr (GATHER) { if (has_next && wid < 4) __builtin_amdgcn_global_load_lds((const unsigned*)S.idx_ptr(nxt, wid * 64 + lane), (LAS unsigned*)(idxtab + ((ui + 1) % 3) * 256 + wid * 64), 4, 0, 0); }
        for (int t = 0; t < nt; t += 2) {
            const bool last = (t == nt - 2);
            const char* a1 = cA + (size_t)(t + 1) * kstep;
            const char* a2 = last ? nA : cA + (size_t)(t + 2) * kstep; const char* b2 = last ? nB : cB + (size_t)(t + 2) * kstep;
            const char* a3 = a2 + kstep; const char* b3 = b2 + kstep;
            if constexpr (GATHER) {
                if (last) {
                    if (has_next) {
#pragma unroll
                        for (int h = 0; h < 2; ++h)
#pragma unroll
                            for (int i = 0; i < 2; ++i) gn[h][i] = (unsigned)idxtab[((ui + 1) % 3) * 256 + h * HALF + RA[i]] * (unsigned)g.lda + (unsigned)CA2[i];
                    }
#pragma unroll
                    for (int h = 0; h < 2; ++h)
#pragma unroll
                        for (int i = 0; i < 2; ++i) g2[h][i] = gn[h][i];
                }
            }
            PG8_LDB(B0, 0, 0); PG8_LDB(B1, 0, 1); PG8_SCHED; PG8_LDA(At, 0, 0); PG8_STAGE_A(PG8_SA(1, 1), a1, 1, gc);
            PG8_WAIT_V(8); PG8_WAIT_L(0); PG8_BAR; PG8_MMA(0, 0, At, B0); PG8_MMA(0, 1, At, B1); PG8_BAR; PG8_SCHED;
            PG8_LDA(At, 0, 1); PG8_STAGE_B(PG8_SB(0, 0), b2); PG8_STAGE_B(PG8_SB(0, 1), b2 + hstepB); PG8_STAGE_A(PG8_SA(0, 0), a2, 0, g2);
            PG8_WAIT_V(8); PG8_WAIT_L(0); PG8_BAR; PG8_MMA(1, 0, At, B0); PG8_MMA(1, 1, At, B1); PG8_BAR; PG8_SCHED;
            PG8_LDB(B0, 1, 0); PG8_LDB(B1, 1, 1); PG8_SCHED; PG8_LDA(At, 1, 0); PG8_STAGE_A(PG8_SA(0, 1), a2, 1, g2);
            PG8_WAIT_V(8); PG8_WAIT_L(0); PG8_BAR; PG8_MMA(0, 0, At, B0); PG8_MMA(0, 1, At, B1); PG8_BAR; PG8_SCHED;
            PG8_LDA(At, 1, 1); PG8_STAGE_B(PG8_SB(1, 0), b3); PG8_STAGE_B(PG8_SB(1, 1), b3 + hstepB); PG8_STAGE_A(PG8_SA(1, 0), a3, 0, g2);
            PG8_WAIT_V(8); PG8_WAIT_L(0); PG8_BAR; PG8_MMA(1, 0, At, B0); PG8_MMA(1, 1, At, B1); PG8_BAR; PG8_SCHED;
        }
        if constexpr (ALIGN_EPI) { if (wr == 0) PG8_BAR; }
        cur.sel = ui % 3;
        E(acc, cur, wr, wc, fr, fq);
        if (!has_next) break;
#pragma unroll
        for (int a = 0; a < 2; ++a)
#pragma unroll
            for (int b = 0; b < 2; ++b)
#pragma unroll
                for (int m = 0; m < 4; ++m)
#pragma unroll
                    for (int n = 0; n < 2; ++n) acc[a][b][m][n] = (f32x4){0.f, 0.f, 0.f, 0.f};
        cur = nxt; cA = nA; cB = nB; ++ui;
        if constexpr (SWAPMODE) swapc = (cur.aux != 0);
        if constexpr (GATHER) {
#pragma unroll
            for (int h = 0; h < 2; ++h)
#pragma unroll
                for (int i = 0; i < 2; ++i) { gc[h][i] = gn[h][i]; g2[h][i] = gn[h][i]; }
        }
        if constexpr (ALIGN_EPI) { if (wr == 1) PG8_BAR; }
    }
    PG8_WAIT_V(0);
    if constexpr (!ALIGN_EPI) { if (wr == 0) PG8_BAR; }
    PG8_BAR;
#undef PG8_SA
#undef PG8_SB
#undef PG8_STG
#undef PG8_STAGE_A
#undef PG8_STAGE_B
#undef PG8_LDA
#undef PG8_LDB
#undef PG8_MMA
#undef PG8_WAIT_V
#undef PG8_WAIT_L
#undef PG8_BAR
#undef PG8_SCHED
}

constexpr int NXCD = 8, WGM = 8;
struct StaticOrder {
    int nM, nN, nwg, G, c, swap_from;
    __device__ void init(int M, int N, int G_, int c_, int swap_from_ = 1 << 30) { nM = M / BM; nN = N / BM; nwg = nM * nN; G = G_; c = c_; swap_from = swap_from_; }
    __device__ bool next(int i, Unit& u) const {
        const long L = (long)i * G + c; if (L >= nwg) return false;
        int wgid = (int)L; { const int q = nwg / NXCD, r = nwg % NXCD, xcd = wgid % NXCD, off = wgid / NXCD; wgid = (xcd < r ? xcd * (q + 1) : r * (q + 1) + (xcd - r) * q) + off; }
        const int nig = WGM * nN, gid = wgid / nig, fm = gid * WGM, gsz = (nM - fm) < WGM ? (nM - fm) : WGM;
        u.pm = fm + ((wgid % nig) % gsz); u.pn = (wgid % nig) / gsz; u.e = 0; u.aux = (u.pn >= swap_from) ? 1 : 0; u.lbase = 0; u.koff = 0; return true;
    }
    __device__ const int* idx_ptr(const Unit&, int) const { return nullptr; }
};
struct QkvOrder {
    int G, c;
    __device__ bool next(int i, Unit& u) const {
        const int L = i * G + c; if (L >= 400) return false;
        if (L < 384) { u.pm = (L / 48) * 8 + (L % 8); u.pn = (L % 48) / 8; } else { const int r = L - 384; u.pm = 64 + (r % 8); u.pn = 4 + r / 8; }
        u.e = 0; u.aux = 0; u.lbase = 0; u.koff = 0; return true;
    }
    __device__ const int* idx_ptr(const Unit&, int) const { return nullptr; }
};
struct MoeOrder {
    const LAS int* tab; const int* list; int G, c;
    __device__ bool next(int i, Unit& u) const {
        const int L0 = i * G + c; const int total = tab[16] * 4; if (L0 >= total) return false;
        int L = L0;
        if (G == 256 && (i + 1) * 256 <= total) { const int x = c & 7, j = c >> 3; L = i * 256 + (((x >> 1) * 16 + (j >> 1)) << 2) + (((x & 1) << 1) | (j & 1)); }
        const int T = L >> 2; int e = 0;
#pragma unroll
        for (int j = 1; j < 16; ++j) e += (T >= tab[j]) ? 1 : 0;
        const int mt = T - tab[e]; int valid = tab[17 + e] - mt * 256; if (valid > 256) valid = 256;
        u.pm = T; u.pn = L & 3; u.e = e; u.aux = valid; u.lbase = e * NT + mt * 256; u.koff = 0; return true;
    }
    __device__ const int* idx_ptr(const Unit& u, int r) const { return list + u.lbase + (r < u.aux ? r : 0); }
};
}

__device__ __forceinline__ unsigned cvt_pk_bf16(float lo, float hi) { typedef __bf16 bf2 __attribute__((ext_vector_type(2))); f32x2 v = {lo, hi}; bf2 b = __builtin_convertvector(v, bf2); return __builtin_bit_cast(unsigned, b); }

struct EpiGemm1 {
    static constexpr bool PERM = true;
    bf16_t* UV; float* vsq;
    __device__ __forceinline__ void operator()(const f32x4 (&acc)[2][2][4][2], const pg8::Unit& u, int wr, int wc, int fr, int fq) const {
        const int row0 = u.pm * 256 + wr * 64 + fr, col0 = u.pn * 256 + wc * 32 + 8 * fq; const bool isv = u.pn >= 8;
#pragma unroll
        for (int ai = 0; ai < 2; ++ai)
#pragma unroll
            for (int m = 0; m < 4; ++m) { const int row = row0 + ai * 128 + m * 16; bf16_t* rowp = UV + (size_t)row * 4096 + col0; float ss = 0.f;
#pragma unroll
                for (int bj = 0; bj < 2; ++bj) { const f32x4 v0 = acc[ai][bj][m][0], v1 = acc[ai][bj][m][1];
                    const float g0 = gelu_tanh(v0[0]), g1 = gelu_tanh(v0[1]), g2 = gelu_tanh(v0[2]), g3 = gelu_tanh(v0[3]), g4 = gelu_tanh(v1[0]), g5 = gelu_tanh(v1[1]), g6 = gelu_tanh(v1[2]), g7 = gelu_tanh(v1[3]);
                    ss += (g0 * g0 + g1 * g1) + (g2 * g2 + g3 * g3) + (g4 * g4 + g5 * g5) + (g6 * g6 + g7 * g7);
                    u32x4 w; w.x = cvt_pk_bf16(g0, g1); w.y = cvt_pk_bf16(g2, g3); w.z = cvt_pk_bf16(g4, g5); w.w = cvt_pk_bf16(g6, g7);
                    *(u32x4*)(rowp + bj * 128) = w; }
                if (isv) { ss += __shfl_xor(ss, 16); ss += __shfl_xor(ss, 32); if (fq == 0) vsq[(size_t)row * 32 + (u.pn - 8) * 4 + wc] = ss; } }
    }
};
struct EpiGemm1Q {
    static constexpr bool PERM = true;
    bf16_t* UV; float* vsq; const float* hs; const unsigned* amax;
    __device__ __forceinline__ void operator()(const f32x4 (&acc)[2][2][4][2], const pg8::Unit& u, int wr, int wc, int fr, int fq) const {
        const int row0 = u.pm * 256 + wr * 64 + fr, col0 = u.pn * 256 + wc * 32 + 8 * fq; const bool isv = u.pn >= 8;
        f32x4 cs[2][2];
#pragma unroll
        for (int bj = 0; bj < 2; ++bj)
#pragma unroll
            for (int n = 0; n < 2; ++n) { const u32x4 a = *(const u32x4*)(amax + col0 + bj * 128 + 4 * n);
                cs[bj][n] = (f32x4){__uint_as_float(a.x), __uint_as_float(a.y), __uint_as_float(a.z), __uint_as_float(a.w)} * (1.f / 127.f); }
        float rscv[2][4];
#pragma unroll
        for (int ai = 0; ai < 2; ++ai)
#pragma unroll
            for (int m = 0; m < 4; ++m) rscv[ai][m] = hs[row0 + ai * 128 + m * 16];
        asm volatile("" : "+v"(rscv[0][0]), "+v"(rscv[0][1]), "+v"(rscv[0][2]), "+v"(rscv[0][3]), "+v"(rscv[1][0]), "+v"(rscv[1][1]), "+v"(rscv[1][2]), "+v"(rscv[1][3]));
#pragma unroll
        for (int ai = 0; ai < 2; ++ai)
#pragma unroll
            for (int m = 0; m < 4; ++m) { const int row = row0 + ai * 128 + m * 16; bf16_t* rowp = UV + (size_t)row * 4096 + col0; float ss = 0.f; const float rsc = rscv[ai][m];
#pragma unroll
                for (int bj = 0; bj < 2; ++bj) { const pg8::v4i32 i0 = __builtin_bit_cast(pg8::v4i32, acc[ai][bj][m][0]), i1 = __builtin_bit_cast(pg8::v4i32, acc[ai][bj][m][1]);
                    const f32x4 v0 = (f32x4){(float)i0[0], (float)i0[1], (float)i0[2], (float)i0[3]} * cs[bj][0] * rsc, v1 = (f32x4){(float)i1[0], (float)i1[1], (float)i1[2], (float)i1[3]} * cs[bj][1] * rsc;
                    const float g0 = gelu_tanh(v0[0]), g1 = gelu_tanh(v0[1]), g2 = gelu_tanh(v0[2]), g3 = gelu_tanh(v0[3]), g4 = gelu_tanh(v1[0]), g5 = gelu_tanh(v1[1]), g6 = gelu_tanh(v1[2]), g7 = gelu_tanh(v1[3]);
                    ss += (g0 * g0 + g1 * g1) + (g2 * g2 + g3 * g3) + (g4 * g4 + g5 * g5) + (g6 * g6 + g7 * g7);
                    u32x4 w; w.x = cvt_pk_bf16(g0, g1); w.y = cvt_pk_bf16(g2, g3); w.z = cvt_pk_bf16(g4, g5); w.w = cvt_pk_bf16(g6, g7);
                    *(u32x4*)(rowp + bj * 128) = w; }
                if (isv) { ss += __shfl_xor(ss, 16); ss += __shfl_xor(ss, 32); if (fq == 0) vsq[(size_t)row * 32 + (u.pn - 8) * 4 + wc] = ss; } }
    }
};
struct EpiGateUpQ {
    static constexpr bool PERM = true;
    bf16_t* HID; const float* hs; const unsigned* amax; const LAS int* idxtab;
    __device__ __forceinline__ void operator()(const f32x4 (&acc)[2][2][4][2], const pg8::Unit& u, int wr, int wc, int fr, int fq) const {
        const int row0 = u.pm * 256 + wr * 64 + fr, col0 = u.pn * 128 + wc * 32 + 8 * fq;
        const unsigned* ap = amax + u.e * 1024 + u.pn * 256 + wc * 32 + 8 * fq;
        f32x4 cs[2][2];
#pragma unroll
        for (int bj = 0; bj < 2; ++bj)
#pragma unroll
            for (int n = 0; n < 2; ++n) { const u32x4 a = *(const u32x4*)(ap + bj * 128 + 4 * n);
                cs[bj][n] = (f32x4){__uint_as_float(a.x), __uint_as_float(a.y), __uint_as_float(a.z), __uint_as_float(a.w)} * (1.f / 127.f); }
        const LAS int* tab = idxtab + u.sel * 256 + wr * 64 + fr;
        float rscv[2][4];
#pragma unroll
        for (int ai = 0; ai < 2; ++ai)
#pragma unroll
            for (int m = 0; m < 4; ++m) rscv[ai][m] = hs[tab[ai * 128 + m * 16]];
        asm volatile("" : "+v"(rscv[0][0]), "+v"(rscv[0][1]), "+v"(rscv[0][2]), "+v"(rscv[0][3]), "+v"(rscv[1][0]), "+v"(rscv[1][1]), "+v"(rscv[1][2]), "+v"(rscv[1][3]));
#pragma unroll
        for (int ai = 0; ai < 2; ++ai)
#pragma unroll
            for (int m = 0; m < 4; ++m) { const float rsc = rscv[ai][m];
                const pg8::v4i32 ig0 = __builtin_bit_cast(pg8::v4i32, acc[ai][0][m][0]), ig1 = __builtin_bit_cast(pg8::v4i32, acc[ai][0][m][1]), iu0 = __builtin_bit_cast(pg8::v4i32, acc[ai][1][m][0]), iu1 = __builtin_bit_cast(pg8::v4i32, acc[ai][1][m][1]);
                const f32x4 g0 = (f32x4){(float)ig0[0], (float)ig0[1], (float)ig0[2], (float)ig0[3]} * cs[0][0] * rsc, g1 = (f32x4){(float)ig1[0], (float)ig1[1], (float)ig1[2], (float)ig1[3]} * cs[0][1] * rsc;
                const f32x4 u0 = (f32x4){(float)iu0[0], (float)iu0[1], (float)iu0[2], (float)iu0[3]} * cs[1][0] * rsc, u1 = (f32x4){(float)iu1[0], (float)iu1[1], (float)iu1[2], (float)iu1[3]} * cs[1][1] * rsc;
                u32x4 w;
                w.x = cvt_pk_bf16(silu_f(g0[0]) * u0[0], silu_f(g0[1]) * u0[1]); w.y = cvt_pk_bf16(silu_f(g0[2]) * u0[2], silu_f(g0[3]) * u0[3]);
                w.z = cvt_pk_bf16(silu_f(g1[0]) * u1[0], silu_f(g1[1]) * u1[1]); w.w = cvt_pk_bf16(silu_f(g1[2]) * u1[2], silu_f(g1[3]) * u1[3]);
                *(u32x4*)(HID + (size_t)(row0 + ai * 128 + m * 16) * DE + col0) = w; }
    }
};
struct EpiQkvQ {
    static constexpr bool PERM = false;
    bf16_t *Q, *K, *V; const float* hs; const unsigned* amax;
    __device__ __forceinline__ void operator()(const f32x4 (&acc)[2][2][4][2], const pg8::Unit& u, int wr, int wc, int fr, int fq) const {
        const int row0 = u.pm * 256 + wr * 64 + fr; const bool rope = (u.pn < 5) && (u.pm < 64);
        bf16_t* base; int ld, colt; float sc = 1.f;
        if (u.pn < 4) { base = Q; ld = 1024; colt = u.pn * 256; sc = QSCALE; } else if (u.pn == 4) { base = K; ld = KVD; colt = 0; } else { base = V; ld = KVD; colt = 0; }
        const int col0 = colt + wc * 32 + 4 * fq; const unsigned* ap = amax + u.pn * 256 + wc * 32 + 4 * fq;
        f32x4 cs[2][2];
#pragma unroll
        for (int bj = 0; bj < 2; ++bj)
#pragma unroll
            for (int n = 0; n < 2; ++n) { const u32x4 a = *(const u32x4*)(ap + bj * 128 + 16 * n);
                cs[bj][n] = (f32x4){__uint_as_float(a.x), __uint_as_float(a.y), __uint_as_float(a.z), __uint_as_float(a.w)} * (1.f / 127.f); }
        float rscv[2][4];
#pragma unroll
        for (int ai = 0; ai < 2; ++ai)
#pragma unroll
            for (int m = 0; m < 4; ++m) rscv[ai][m] = hs[row0 + ai * 128 + m * 16];
        asm volatile("" : "+v"(rscv[0][0]), "+v"(rscv[0][1]), "+v"(rscv[0][2]), "+v"(rscv[0][3]), "+v"(rscv[1][0]), "+v"(rscv[1][1]), "+v"(rscv[1][2]), "+v"(rscv[1][3]));
        float inv[4];
#pragma unroll
        for (int i = 0; i < 4; ++i) inv[i] = exp2f(-(float)(4 * fq + i) * (13.287712379549449f / 16.f)) * 0.15915494309189535f;
#pragma unroll
        for (int ai = 0; ai < 2; ++ai)
#pragma unroll
            for (int m = 0; m < 4; ++m) { const int row = row0 + ai * 128 + m * 16; const int pos = row & 2047; const float pp = (float)((wc & 1) ? (pos & 63) : (pos >> 6));
                const float rsc = rscv[ai][m];
                float cs_[4], sn[4];
#pragma unroll
                for (int i = 0; i < 4; ++i) { float rev = pp * inv[i]; rev -= floorf(rev); sn[i] = rope ? __builtin_amdgcn_sinf(rev) : 0.f; cs_[i] = rope ? __builtin_amdgcn_cosf(rev) : 1.f; }
#pragma unroll
                for (int bj = 0; bj < 2; ++bj) { const pg8::v4i32 i1 = __builtin_bit_cast(pg8::v4i32, acc[ai][bj][m][0]), i2 = __builtin_bit_cast(pg8::v4i32, acc[ai][bj][m][1]);
                    const f32x4 x1 = (f32x4){(float)i1[0], (float)i1[1], (float)i1[2], (float)i1[3]} * cs[bj][0] * rsc, x2 = (f32x4){(float)i2[0], (float)i2[1], (float)i2[2], (float)i2[3]} * cs[bj][1] * rsc;
                    float o1[4], o2[4];
#pragma unroll
                    for (int i = 0; i < 4; ++i) { o1[i] = (x1[i] * cs_[i] - x2[i] * sn[i]) * sc; o2[i] = (x2[i] * cs_[i] + x1[i] * sn[i]) * sc; }
                    bf16_t* p = base + (size_t)row * ld + col0 + bj * 128;
                    u32x2 w1, w2; w1.x = cvt_pk_bf16(o1[0], o1[1]); w1.y = cvt_pk_bf16(o1[2], o1[3]); w2.x = cvt_pk_bf16(o2[0], o2[1]); w2.y = cvt_pk_bf16(o2[2], o2[3]);
                    *(u32x2*)p = w1; *(u32x2*)(p + 16) = w2; } }
    }
};
struct EpiGemm2 {
    static constexpr bool PERM = true;
    const float* x0; const float* c0; bf16_t* xbh; const float* modf;
    __device__ __forceinline__ void operator()(const f32x4 (&acc)[2][2][4][2], const pg8::Unit& u, int wr, int wc, int fr, int fq) const {
        const int rowt = u.pm * 256; const bool isx = rowt < NX;
        const float* src = isx ? x0 + (size_t)rowt * D : c0 + (size_t)(rowt - NX) * D; bf16_t* dst = xbh + (size_t)rowt * D;
        const float* g1p = modf + (size_t)(rowt / 2048) * 6144 + 2048;
        const int col0 = u.pn * 256 + wc * 32 + 8 * fq;
        f32x4 g1[2][2];
#pragma unroll
        for (int bj = 0; bj < 2; ++bj)
#pragma unroll
            for (int n = 0; n < 2; ++n) g1[bj][n] = *(const f32x4*)(g1p + col0 + bj * 128 + n * 4);
#pragma unroll
        for (int ai = 0; ai < 2; ++ai)
#pragma unroll
            for (int m = 0; m < 4; ++m) { const size_t off = (size_t)(ai * 128 + wr * 64 + m * 16 + fr) * D + col0;
#pragma unroll
                for (int bj = 0; bj < 2; ++bj) { const f32x4 xa = *(const f32x4*)(src + off + bj * 128), xb = *(const f32x4*)(src + off + bj * 128 + 4);
                    const f32x4 ya = xa + g1[bj][0] * acc[ai][bj][m][0], yb = xb + g1[bj][1] * acc[ai][bj][m][1]; u32x4 w;
                    w.x = cvt_pk_bf16(ya[0], ya[1]); w.y = cvt_pk_bf16(ya[2], ya[3]); w.z = cvt_pk_bf16(yb[0], yb[1]); w.w = cvt_pk_bf16(yb[2], yb[3]);
                    *(u32x4*)(dst + off + bj * 128) = w; } }
    }
};
struct EpiWo {
    static constexpr bool PERM = true;
    bf16_t* xbh; const float* modf1;
    __device__ __forceinline__ void operator()(const f32x4 (&acc)[2][2][4][2], const pg8::Unit& u, int wr, int wc, int fr, int fq) const {
        const int rowt = u.pm * 256; bf16_t* dst = xbh + (size_t)rowt * D; const float* g1p = modf1 + (size_t)(rowt / 2048) * 6144 + 2048;
        const int col0 = u.pn * 256 + wc * 32 + 8 * fq;
        f32x4 g1[2][2];
#pragma unroll
        for (int bj = 0; bj < 2; ++bj)
#pragma unroll
            for (int n = 0; n < 2; ++n) g1[bj][n] = *(const f32x4*)(g1p + col0 + bj * 128 + n * 4);
#pragma unroll
        for (int ai = 0; ai < 2; ++ai)
#pragma unroll
            for (int m = 0; m < 4; ++m) { const size_t off = (size_t)(ai * 128 + wr * 64 + m * 16 + fr) * D + col0;
#pragma unroll
                for (int bj = 0; bj < 2; ++bj) { bf16_t* p = dst + off + bj * 128; const u32x4 xw = *(const u32x4*)p;
                    const f32x4 xa = (f32x4){__uint_as_float(xw.x << 16), __uint_as_float(xw.x & 0xffff0000u), __uint_as_float(xw.y << 16), __uint_as_float(xw.y & 0xffff0000u)};
                    const f32x4 xb = (f32x4){__uint_as_float(xw.z << 16), __uint_as_float(xw.z & 0xffff0000u), __uint_as_float(xw.w << 16), __uint_as_float(xw.w & 0xffff0000u)};
                    const f32x4 ya = xa + g1[bj][0] * acc[ai][bj][m][0], yb = xb + g1[bj][1] * acc[ai][bj][m][1]; u32x4 w;
                    w.x = cvt_pk_bf16(ya[0], ya[1]); w.y = cvt_pk_bf16(ya[2], ya[3]); w.z = cvt_pk_bf16(yb[0], yb[1]); w.w = cvt_pk_bf16(yb[2], yb[3]);
                    *(u32x4*)p = w; } }
    }
};
struct EpiGateUp {
    static constexpr bool PERM = true;
    bf16_t* HID;
    __device__ __forceinline__ void operator()(const f32x4 (&acc)[2][2][4][2], const pg8::Unit& u, int wr, int wc, int fr, int fq) const {
        const int row0 = u.pm * 256 + wr * 64 + fr, col0 = u.pn * 128 + wc * 32 + 8 * fq;
#pragma unroll
        for (int ai = 0; ai < 2; ++ai)
#pragma unroll
            for (int m = 0; m < 4; ++m) { const f32x4 g0 = acc[ai][0][m][0], g1 = acc[ai][0][m][1], u0 = acc[ai][1][m][0], u1 = acc[ai][1][m][1]; u32x4 w;
                w.x = cvt_pk_bf16(silu_f(g0[0]) * u0[0], silu_f(g0[1]) * u0[1]); w.y = cvt_pk_bf16(silu_f(g0[2]) * u0[2], silu_f(g0[3]) * u0[3]);
                w.z = cvt_pk_bf16(silu_f(g1[0]) * u1[0], silu_f(g1[1]) * u1[1]); w.w = cvt_pk_bf16(silu_f(g1[2]) * u1[2], silu_f(g1[3]) * u1[3]);
                *(u32x4*)(HID + (size_t)(row0 + ai * 128 + m * 16) * DE + col0) = w; }
    }
};
struct EpiDown {
    static constexpr bool PERM = true;
    bf16_t* Y;
    __device__ __forceinline__ void operator()(const f32x4 (&acc)[2][2][4][2], const pg8::Unit& u, int wr, int wc, int fr, int fq) const {
        const int row0 = u.pm * 256 + wr * 64 + fr, col0 = u.pn * 256 + wc * 32 + 8 * fq;
#pragma unroll
        for (int ai = 0; ai < 2; ++ai)
#pragma unroll
            for (int m = 0; m < 4; ++m) { bf16_t* rowp = Y + (size_t)(row0 + ai * 128 + m * 16) * D + col0;
#pragma unroll
                for (int bj = 0; bj < 2; ++bj) { const f32x4 v0 = acc[ai][bj][m][0], v1 = acc[ai][bj][m][1]; u32x4 w;
                    w.x = cvt_pk_bf16(v0[0], v0[1]); w.y = cvt_pk_bf16(v0[2], v0[3]); w.z = cvt_pk_bf16(v1[0], v1[1]); w.w = cvt_pk_bf16(v1[2], v1[3]);
                    *(u32x4*)(rowp + bj * 128) = w; } }
    }
};
struct EpiQkv {
    static constexpr bool PERM = false;
    bf16_t *Q, *K, *V;
    __device__ __forceinline__ void operator()(const f32x4 (&acc)[2][2][4][2], const pg8::Unit& u, int wr, int wc, int fr, int fq) const {
        const int row0 = u.pm * 256 + wr * 64 + fr; const bool rope = (u.pn < 5) && (u.pm < 64);
        bf16_t* base; int ld, colt; float sc = 1.f;
        if (u.pn < 4) { base = Q; ld = 1024; colt = u.pn * 256; sc = QSCALE; } else if (u.pn == 4) { base = K; ld = KVD; colt = 0; } else { base = V; ld = KVD; colt = 0; }
        const int col0 = colt + wc * 32 + 4 * fq;
        float inv[4];
#pragma unroll
        for (int i = 0; i < 4; ++i) inv[i] = exp2f(-(float)(4 * fq + i) * (13.287712379549449f / 16.f)) * 0.15915494309189535f;
#pragma unroll
        for (int ai = 0; ai < 2; ++ai)
#pragma unroll
            for (int m = 0; m < 4; ++m) { const int row = row0 + ai * 128 + m * 16; const int pos = row & 2047; const float pp = (float)((wc & 1) ? (pos & 63) : (pos >> 6));
                float cs[4], sn[4];
#pragma unroll
                for (int i = 0; i < 4; ++i) { float rev = pp * inv[i]; rev -= floorf(rev); sn[i] = rope ? __builtin_amdgcn_sinf(rev) : 0.f; cs[i] = rope ? __builtin_amdgcn_cosf(rev) : 1.f; }
#pragma unroll
                for (int bj = 0; bj < 2; ++bj) { const f32x4 x1 = acc[ai][bj][m][0], x2 = acc[ai][bj][m][1]; float o1[4], o2[4];
#pragma unroll
                    for (int i = 0; i < 4; ++i) { o1[i] = (x1[i] * cs[i] - x2[i] * sn[i]) * sc; o2[i] = (x2[i] * cs[i] + x1[i] * sn[i]) * sc; }
                    bf16_t* p = base + (size_t)row * ld + col0 + bj * 128;
                    u32x2 w1, w2; w1.x = cvt_pk_bf16(o1[0], o1[1]); w1.y = cvt_pk_bf16(o1[2], o1[3]); w2.x = cvt_pk_bf16(o2[0], o2[1]); w2.y = cvt_pk_bf16(o2[2], o2[3]);
                    *(u32x2*)p = w1; *(u32x2*)(p + 16) = w2; } }
    }
};

struct CtxSplitOrder {
    int c;
    __device__ bool next(int i, pg8::Unit& u) const { if (i > 0 || c >= 64) return false; const int tile = c >> 1; u.pm = 64 + (tile >> 2); u.pn = tile & 3; u.e = 0; u.aux = c & 1; u.lbase = 0; u.koff = (c & 1) * 2048; return true; }
    __device__ const int* idx_ptr(const pg8::Unit&, int) const { return nullptr; }
};
struct EpiCtxPartial {
    static constexpr bool PERM = true;
    float* cxp;
    __device__ __forceinline__ void operator()(const f32x4 (&acc)[2][2][4][2], const pg8::Unit& u, int wr, int wc, int fr, int fq) const {
        float* dst = cxp + (size_t)u.aux * NCX * D + (size_t)(u.pm * 256 - NX) * D; const int col0 = u.pn * 256 + wc * 32 + 8 * fq;
#pragma unroll
        for (int ai = 0; ai < 2; ++ai)
#pragma unroll
            for (int m = 0; m < 4; ++m) { const size_t off = (size_t)(ai * 128 + wr * 64 + m * 16 + fr) * D + col0;
#pragma unroll
                for (int bj = 0; bj < 2; ++bj) { *(f32x4*)(dst + off + bj * 128) = acc[ai][bj][m][0]; *(f32x4*)(dst + off + bj * 128 + 4) = acc[ai][bj][m][1]; } }
    }
};
__device__ __forceinline__ void phase_gemm1_fast(Frame& F) {
    pg8::Gemm g{F.hq(), F.winq(), D, D, D, 0}; pg8::StaticOrder S; S.init(NT, 4096, F.G, (int)blockIdx.x);
    EpiGemm1Q E{F.u(), F.vsq(), F.hs(), F.amax_in()};
    pg8::gemm_phase<EpiGemm1Q, pg8::StaticOrder, false, false, true, true>(F.lds, g, S, E, nullptr);
}
__device__ __forceinline__ void phase_gemm2_fast(Frame& F) {
    if (F.G == 256) {
        { pg8::Gemm g{F.u(), F.wout(), 2 * U_LD, 2 * AW, 2 * AW, 0}; pg8::StaticOrder S; S.init(NX, D, F.G, (int)blockIdx.x);
          EpiGemm2 E{F.in[I_X], F.in[I_CTX], F.xbh(), F.modf()};
          pg8::gemm_phase<EpiGemm2, pg8::StaticOrder, false, false, true>(F.lds, g, S, E, nullptr); }
        { pg8::Gemm g{F.u(), F.wout(), 2 * U_LD, 2 * AW, AW, 0}; CtxSplitOrder S{(int)blockIdx.x};
          EpiCtxPartial E{F.cxp()};
          pg8::gemm_phase<EpiCtxPartial, CtxSplitOrder, false, false, true>(F.lds, g, S, E, nullptr); }
        return; }
    pg8::Gemm g{F.u(), F.wout(), 2 * U_LD, 2 * AW, 2 * AW, 0}; pg8::StaticOrder S; S.init(NT, D, F.G, (int)blockIdx.x);
    EpiGemm2 E{F.in[I_X], F.in[I_CTX], F.xbh(), F.modf()};
    pg8::gemm_phase<EpiGemm2, pg8::StaticOrder, false, false, true>(F.lds, g, S, E, nullptr);
}
__device__ __forceinline__ void phase_wo_fast(Frame& F) {
    pg8::Gemm g{F.o(), F.wo(), 2 * D, 2 * D, 2 * D, 0}; pg8::StaticOrder S; S.init(NX, D, F.G, (int)blockIdx.x);
    EpiWo E{F.xbh(), F.modf() + (size_t)9 * 6144};
    pg8::gemm_phase<EpiWo, pg8::StaticOrder, false, false, true>(F.lds, g, S, E, nullptr);
}
__device__ __forceinline__ void phase_qkv_fast(Frame& F) {
    pg8::Gemm g{F.hq(), F.wqkvq(), D, D, D, 0}; pg8::QkvOrder S{F.G, (int)blockIdx.x};
    EpiQkvQ E{F.q(), F.k(), F.v(), F.hs(), F.amax_qkv()};
    pg8::gemm_phase<EpiQkvQ, pg8::QkvOrder, false, false, true, true>(F.lds, g, S, E, nullptr);
}
__device__ __forceinline__ LAS int* moe_table(Frame& F, int l) {
    LAS int* tab = (LAS int*)(F.lds + LDSCTL_OFF + 1024);
    const unsigned* cnt = F.ctl() + CW_CNT + 16 * l;
    __syncthreads();
    if (F.tid == 0) { int t = 0; for (int e = 0; e < 16; ++e) { const int n = (int)cnt[e]; tab[e] = t; tab[17 + e] = n; t += (n + 255) >> 8; } tab[16] = t; }
    __syncthreads();
    return tab;
}
__device__ __forceinline__ void phase_gateup_fast(Frame& F, int l) {
    LAS int* tab = moe_table(F, l);
    LAS int* idxtab = (LAS int*)(F.lds + LDSCTL_OFF + 2048);
    pg8::Gemm g{F.hq(), F.guq() + (size_t)l * 16 * 1024 * 1024, D, D, D, (size_t)1024 * 1024}; pg8::MoeOrder S{tab, F.list(), F.G, (int)blockIdx.x};
    EpiGateUpQ E{F.hid(), F.hs(), F.amax_gu() + l * 16 * 1024, idxtab};
    pg8::gemm_phase<EpiGateUpQ, pg8::MoeOrder, true, false, true, true>(F.lds, g, S, E, idxtab);
}
__device__ __forceinline__ void phase_down_fast(Frame& F, int l) {
    LAS int* tab = moe_table(F, l);
    pg8::Gemm g{F.hid(), F.dn() + (size_t)l * 16 * 1024 * 512, 2 * DE, 2 * DE, 2 * DE, (size_t)2 * 1024 * 512}; pg8::MoeOrder S{tab, F.list(), F.G, (int)blockIdx.x};
    EpiDown E{F.y()};
    pg8::gemm_phase<EpiDown, pg8::MoeOrder, false, false, true>(F.lds, g, S, E, nullptr);
}


typedef short s16x4 __attribute__((ext_vector_type(4)));
__device__ __forceinline__ void phase_sgu_fast(Frame& F) {
    constexpr int SA = 136, SB = 264;
    LAS bf16_t* As = (LAS bf16_t*)F.lds; LAS bf16_t* Bs = As + 128 * SA; LAS float* rs = (LAS float*)(Bs + 128 * SB);
    const int tid = F.tid, lane = F.lane, wave = F.wave, wr = wave >> 2, wc = wave & 3, fr = lane & 15, fq = lane >> 4;
    const int nb = F.G >> 3, g = blockIdx.x & 7; int c = blockIdx.x >> 3;
    if ((int)blockIdx.x >= nb * 8 || c >= 144) return;
    __syncthreads();
#pragma unroll
    for (int i = 0; i < 4; ++i) { const int idx = tid + 512 * i, r = idx >> 4, ck = idx & 15;
        *(LAS u32x4*)(As + r * SA + ck * 8) = *(const u32x4*)(F.wsbf() + (size_t)g * 16384 + r * 128 + ck * 8); }
    const int vr0 = tid >> 5, vck = tid & 31;
    const f32x4 ga = *(const f32x4*)(F.in[I_AGV] + g * 256 + vck * 8), gb = *(const f32x4*)(F.in[I_AGV] + g * 256 + vck * 8 + 4);
    float bsv[4];
#pragma unroll
    for (int m = 0; m < 4; ++m) bsv[m] = F.in[I_ABS][g * 128 + wr * 64 + m * 16 + fr];
    auto rstd_of = [&](int cc, int t) { const float* p = F.vsq() + (size_t)(cc * 128 + t) * 32; float s = 0.f;
#pragma unroll
        for (int j = 0; j < 32; j += 4) { const f32x4 q = *(const f32x4*)(p + j); s += (q.x + q.y) + (q.z + q.w); }
        return rsqrtf(s * (1.f / AW) + EPS); };
    if (tid < 128) rs[tid] = rstd_of(c, tid);
    u32x4 vreg[8];
    { const bf16_t* vb = F.u() + (size_t)c * 128 * 4096 + 2048 + g * 256 + vck * 8;
#pragma unroll
      for (int i = 0; i < 8; ++i) vreg[i] = *(const u32x4*)(vb + (size_t)(vr0 + 16 * i) * 4096); }
    __syncthreads();
    int cur = 0;
    for (; c < 144; c += nb) {
        const int cn = c + nb; const bool has_next = cn < 144;
#pragma unroll
        for (int i = 0; i < 8; ++i) { const int r = vr0 + 16 * i; const u32x4 w = vreg[i]; const float sc = rs[cur * 128 + r]; u32x4 o;
            o.x = cvt_pk_bf16(__uint_as_float(w.x << 16) * sc * ga.x, __uint_as_float(w.x & 0xffff0000u) * sc * ga.y);
            o.y = cvt_pk_bf16(__uint_as_float(w.y << 16) * sc * ga.z, __uint_as_float(w.y & 0xffff0000u) * sc * ga.w);
            o.z = cvt_pk_bf16(__uint_as_float(w.z << 16) * sc * gb.x, __uint_as_float(w.z & 0xffff0000u) * sc * gb.y);
            o.w = cvt_pk_bf16(__uint_as_float(w.w << 16) * sc * gb.z, __uint_as_float(w.w & 0xffff0000u) * sc * gb.w);
            *(LAS u32x4*)(Bs + r * SB + vck * 8) = o; }
        bf16_t* ub = F.u() + (size_t)c * 128 * 4096 + g * 256 + vck * 8;
        u32x4 ureg[8];
#pragma unroll
        for (int i = 0; i < 8; ++i) ureg[i] = *(const u32x4*)(ub + (size_t)(vr0 + 16 * i) * 4096);
        if (has_next) { const bf16_t* vb = F.u() + (size_t)cn * 128 * 4096 + 2048 + g * 256 + vck * 8;
#pragma unroll
            for (int i = 0; i < 8; ++i) vreg[i] = *(const u32x4*)(vb + (size_t)(vr0 + 16 * i) * 4096);
            if (tid < 128) rs[(cur ^ 1) * 128 + tid] = rstd_of(cn, tid); }
        __syncthreads();
        f32x4 acc[4][4];
#pragma unroll
        for (int m = 0; m < 4; ++m)
#pragma unroll
            for (int n = 0; n < 4; ++n) acc[m][n] = (f32x4){0.f, 0.f, 0.f, 0.f};
#pragma unroll
        for (int ks = 0; ks < 4; ++ks) {
            bf16x8 bw[4], av[4];
#pragma unroll
            for (int m = 0; m < 4; ++m) bw[m] = *(const LAS bf16x8*)(As + (wr * 64 + m * 16 + fr) * SA + ks * 32 + fq * 8);
#pragma unroll
            for (int n = 0; n < 4; ++n) { const LAS bf16_t* p = Bs + (ks * 32 + fq * 8 + (fr >> 2)) * SB + wc * 64 + n * 16 + 4 * (fr & 3);
                const s16x4 lo = __builtin_bit_cast(s16x4, __builtin_amdgcn_ds_read_tr16_b64_v4i16((LAS s16x4*)p));
                const s16x4 hi = __builtin_bit_cast(s16x4, __builtin_amdgcn_ds_read_tr16_b64_v4i16((LAS s16x4*)(p + 4 * SB)));
                av[n] = (bf16x8){lo[0], lo[1], lo[2], lo[3], hi[0], hi[1], hi[2], hi[3]}; }
#pragma unroll
            for (int m = 0; m < 4; ++m)
#pragma unroll
                for (int n = 0; n < 4; ++n) acc[m][n] = __builtin_amdgcn_mfma_f32_16x16x32_bf16(av[n], bw[m], acc[m][n], 0, 0, 0);
        }
        __syncthreads();
#pragma unroll
        for (int m = 0; m < 4; ++m)
#pragma unroll
            for (int n = 0; n < 4; ++n) { const f32x4 a = acc[m][n]; u32x2 o; o.x = cvt_pk_bf16(a[0] + bsv[m], a[1] + bsv[m]); o.y = cvt_pk_bf16(a[2] + bsv[m], a[3] + bsv[m]);
                *(LAS u32x2*)(Bs + (wr * 64 + m * 16 + fr) * SB + wc * 64 + n * 16 + 4 * fq) = o; }
        __syncthreads();
#pragma unroll
        for (int i = 0; i < 8; ++i) { const int r = vr0 + 16 * i; const u32x4 z = *(const LAS u32x4*)(Bs + r * SB + vck * 8); const u32x4 w = ureg[i]; u32x4 o;
            o.x = cvt_pk_bf16(__uint_as_float(w.x << 16) * __uint_as_float(z.x << 16), __uint_as_float(w.x & 0xffff0000u) * __uint_as_float(z.x & 0xffff0000u));
            o.y = cvt_pk_bf16(__uint_as_float(w.y << 16) * __uint_as_float(z.y << 16), __uint_as_float(w.y & 0xffff0000u) * __uint_as_float(z.y & 0xffff0000u));
            o.z = cvt_pk_bf16(__uint_as_float(w.z << 16) * __uint_as_float(z.z << 16), __uint_as_float(w.z & 0xffff0000u) * __uint_as_float(z.z & 0xffff0000u));
            o.w = cvt_pk_bf16(__uint_as_float(w.w << 16) * __uint_as_float(z.w << 16), __uint_as_float(w.w & 0xffff0000u) * __uint_as_float(z.w & 0xffff0000u));
            *(u32x4*)(ub + (size_t)r * 4096) = o; }
        __syncthreads();
        cur ^= 1;
    }
}

namespace att {
typedef float f32x16 __attribute__((ext_vector_type(16)));
constexpr int SLOTB = 8192, LDS_K = 0, LDS_V = 3 * SLOTB, LDS_WS = 7 * SLOTB, LDS_OST = LDS_WS + 8 * 512, LDS_TOTAL = LDS_OST + 8 * 4096;
__device__ __forceinline__ int crow(int r, int hi) { return (r & 3) + 8 * (r >> 2) + 4 * hi; }
#define ATT_WAIT_BAR(N) asm volatile("s_waitcnt vmcnt(" #N ") lgkmcnt(0)\n\ts_barrier" ::: "memory")
#define ATT_BAR() asm volatile("s_waitcnt lgkmcnt(0)\n\ts_barrier" ::: "memory")
__device__ __forceinline__ void glds16(const void* gsrc, unsigned lds_dst) { unsigned keep;
    asm volatile("s_mov_b32 %0, m0\n\ts_mov_b32 m0, %2\n\ts_nop 0\n\tglobal_load_lds_dwordx4 %1, off\n\ts_mov_b32 m0, %0" : "=&s"(keep) : "v"(gsrc), "s"(lds_dst) : "memory"); }
__device__ __forceinline__ s16x4 vtr(const LAS char* p) { return __builtin_bit_cast(s16x4, __builtin_amdgcn_ds_read_tr16_b64_v4i16((LAS s16x4*)p)); }

template <int MODE> __device__ __forceinline__ void attn_unit(Frame& F, int b, int hk, int qblk) {
    const int lane = F.lane, wave = F.wave, r32 = lane & 31, hi = lane >> 5;
    const int grp = wave >> 2, wq = wave & 3;
    const int half = grp;
    const int head = hk * 4 + wq, s = qblk * 128;
    LAS char* lds = (LAS char*)F.lds;
    LAS float* wsf = (LAS float*)(lds + LDS_WS) + wave * 128;
    const unsigned lds0 = (unsigned)(size_t)lds;
    const bf16_t* Qw = F.q() + (size_t)(b * SEQ + s + half * 64) * 1024 + head * 64;
    bf16x8 qr[2][4];
#pragma unroll
    for (int sb = 0; sb < 2; ++sb)
#pragma unroll
        for (int d0 = 0; d0 < 4; ++d0) qr[sb][d0] = *(const bf16x8*)(Qw + (size_t)(sb * 32 + r32) * 1024 + d0 * 16 + hi * 8);
    const int t_lo = (2 - 2 * qblk) > 0 ? (2 - 2 * qblk) : 0, t_hi = (33 - 2 * qblk) < 5 ? (33 - 2 * qblk) : 5, ntl = 4 + (t_hi - t_lo + 1);
    const bf16_t* Kc = F.k() + (size_t)(NX + b * CTXL) * KVD + hk * 64; const bf16_t* Vc = F.v() + (size_t)(NX + b * CTXL) * KVD + hk * 64;
    const bf16_t* Kx = F.k() + (size_t)(b * SEQ) * KVD + hk * 64; const bf16_t* Vx = F.v() + (size_t)(b * SEQ) * KVD + hk * 64;
    const int koff = lane * KVD + wave * 8;
    const int voff = (16 * (wave & 3) + (lane >> 2)) * KVD + (wave >> 2) * 32 + (lane & 3) * 8;
#define ATT_DMA(i) do { const int ii = (i); const bf16_t *kp, *vp; \
        if (ii < 4) { kp = Kc + (size_t)ii * 64 * KVD; vp = Vc + (size_t)ii * 64 * KVD; } else { const int kpos0 = s - 128 + 64 * (t_lo + ii - 4); kp = Kx + (size_t)kpos0 * KVD; vp = Vx + (size_t)kpos0 * KVD; } \
        glds16(kp + koff, (unsigned)__builtin_amdgcn_readfirstlane(lds0 + LDS_K + (ii % 3) * SLOTB + wave * 1024)); \
        glds16(vp + voff, (unsigned)__builtin_amdgcn_readfirstlane(lds0 + LDS_V + (ii & 3) * SLOTB + wave * 1024)); } while (0)
    asm volatile("s_waitcnt vmcnt(0)" ::: "memory");
    ATT_DMA(0); ATT_DMA(1);
    const float m0 = F.in[I_BSINK][head] * LOG2E;
    float m[2] = {m0, m0}, l[2] = {hi == 0 ? 1.f : 0.f, hi == 0 ? 1.f : 0.f};
    f32x16 o[2][2];
#pragma unroll
    for (int sb = 0; sb < 2; ++sb)
#pragma unroll
        for (int r = 0; r < 16; ++r) { o[sb][0][r] = 0.f; o[sb][1][r] = 0.f; }
    f32x16 p0[2], p1[2]; bf16x8 pa[2][4]; bool resc[2] = {false, false};
#pragma unroll
    for (int sb = 0; sb < 2; ++sb) {
#pragma unroll
        for (int r = 0; r < 16; ++r) { p0[sb][r] = 0.f; p1[sb][r] = 0.f; }
#pragma unroll
        for (int ks = 0; ks < 4; ++ks) pa[sb][ks] = (bf16x8){0, 0, 0, 0, 0, 0, 0, 0}; }
    ATT_WAIT_BAR(2);
    if (grp) ATT_BAR();
    bool act_prev = false;
    for (int j = 0; j <= ntl; ++j) {
        const int t = j < 4 ? -1 : t_lo + j - 4;
        const bool act = (j < ntl) && (t != 5 * (1 - half));
        const bool issue = j + 2 < ntl;
        if (issue) ATT_DMA(j + 2);
        if (act && MODE != 2) {
            const LAS char* kb = lds + LDS_K + (j % 3) * SLOTB + hi * 1024 + r32 * 16;
#pragma unroll
            for (int sb = 0; sb < 2; ++sb) { const float nm = -m[sb];
#pragma unroll
                for (int r = 0; r < 16; ++r) { p0[sb][r] = nm; p1[sb][r] = nm; } }
#pragma unroll
            for (int d0 = 0; d0 < 4; ++d0) { const bf16x8 b0 = *(const LAS bf16x8*)(kb + d0 * 2048), b1 = *(const LAS bf16x8*)(kb + d0 * 2048 + 512);
#pragma unroll
                for (int sb = 0; sb < 2; ++sb) { p0[sb] = __builtin_amdgcn_mfma_f32_32x32x16_bf16(b0, qr[sb][d0], p0[sb], 0, 0, 0); p1[sb] = __builtin_amdgcn_mfma_f32_32x32x16_bf16(b1, qr[sb][d0], p1[sb], 0, 0, 0); } }
        }
        if (act_prev && MODE != 2) {
            const LAS char* vp = lds + LDS_V + ((j - 1) & 3) * SLOTB + ((lane >> 4) & 1) * 32 + (lane & 3) * 8 + (4 * hi + ((lane & 15) >> 2)) * 64;
#pragma unroll
            for (int d0 = 0; d0 < 2; ++d0)
#pragma unroll
                for (int ks = 0; ks < 4; ++ks) { const s16x4 lo = vtr(vp + d0 * 4096 + ks * 1024), hh = vtr(vp + d0 * 4096 + ks * 1024 + 512);
                    const bf16x8 vf = (bf16x8){lo[0], lo[1], lo[2], lo[3], hh[0], hh[1], hh[2], hh[3]};
#pragma unroll
                    for (int sb = 0; sb < 2; ++sb) o[sb][d0] = __builtin_amdgcn_mfma_f32_32x32x16_bf16(pa[sb][ks], vf, o[sb][d0], 0, 0, 0); }
        }
        if (issue) { ATT_WAIT_BAR(2); } else { ATT_WAIT_BAR(0); }
        if (act && MODE != 1) {
#pragma unroll
            for (int sb = 0; sb < 2; ++sb) {
                const int qo = sb * 32 + r32;
                if (t == half) {
#pragma unroll
                    for (int r = 0; r < 16; ++r) { const int kv = crow(r, hi); if (kv < qo) p0[sb][r] = -INFINITY; if (kv + 32 < qo) p1[sb][r] = -INFINITY; }
                } else if (t == 4 + half) {
#pragma unroll
                    for (int r = 0; r < 16; ++r) { const int kv = crow(r, hi); if (kv > qo) p0[sb][r] = -INFINITY; if (kv + 32 > qo) p1[sb][r] = -INFINITY; }
                }
#define ATT_MX3(a, b, c) __builtin_fmaxf(__builtin_fmaxf((a), (b)), (c))
                float ra = ATT_MX3(p0[sb][0], p0[sb][1], p1[sb][0]), rb = ATT_MX3(p0[sb][2], p0[sb][3], p1[sb][1]); ra = ATT_MX3(ra, p1[sb][2], p1[sb][3]);
#pragma unroll
                for (int r = 4; r < 16; r += 4) { ra = ATT_MX3(ra, p0[sb][r], p0[sb][r + 1]); rb = ATT_MX3(rb, p0[sb][r + 2], p0[sb][r + 3]); ra = ATT_MX3(ra, p1[sb][r], p1[sb][r + 1]); rb = ATT_MX3(rb, p1[sb][r + 2], p1[sb][r + 3]); }
#undef ATT_MX3
                float rm = __builtin_fmaxf(ra, rb);
                rm = __builtin_fmaxf(rm, __shfl_xor(rm, 32));
                resc[sb] = __any(rm > 8.f) != 0;
                if (resc[sb]) { const float dl = __builtin_fmaxf(rm, 0.f); m[sb] += dl;
#pragma unroll
                    for (int r = 0; r < 16; ++r) { p0[sb][r] -= dl; p1[sb][r] -= dl; }
                    const float f = __builtin_amdgcn_exp2f(-dl); l[sb] *= f; if (hi == 0) wsf[sb * 32 + r32] = f; }
                f32x2 rs2 = (f32x2){0.f, 0.f};
#pragma unroll
                for (int r = 0; r < 16; r += 2) { p0[sb][r] = __builtin_amdgcn_exp2f(p0[sb][r]); p0[sb][r + 1] = __builtin_amdgcn_exp2f(p0[sb][r + 1]); p1[sb][r] = __builtin_amdgcn_exp2f(p1[sb][r]); p1[sb][r + 1] = __builtin_amdgcn_exp2f(p1[sb][r + 1]);
                    rs2 += (f32x2){p0[sb][r], p0[sb][r + 1]}; rs2 += (f32x2){p1[sb][r], p1[sb][r + 1]}; }
                l[sb] += rs2.x + rs2.y;
                u32x4 w;
                w.x = cvt_pk_bf16(p0[sb][0], p0[sb][1]); w.y = cvt_pk_bf16(p0[sb][2], p0[sb][3]); w.z = cvt_pk_bf16(p0[sb][4], p0[sb][5]); w.w = cvt_pk_bf16(p0[sb][6], p0[sb][7]); pa[sb][0] = __builtin_bit_cast(bf16x8, w);
                w.x = cvt_pk_bf16(p0[sb][8], p0[sb][9]); w.y = cvt_pk_bf16(p0[sb][10], p0[sb][11]); w.z = cvt_pk_bf16(p0[sb][12], p0[sb][13]); w.w = cvt_pk_bf16(p0[sb][14], p0[sb][15]); pa[sb][1] = __builtin_bit_cast(bf16x8, w);
                w.x = cvt_pk_bf16(p1[sb][0], p1[sb][1]); w.y = cvt_pk_bf16(p1[sb][2], p1[sb][3]); w.z = cvt_pk_bf16(p1[sb][4], p1[sb][5]); w.w = cvt_pk_bf16(p1[sb][6], p1[sb][7]); pa[sb][2] = __builtin_bit_cast(bf16x8, w);
                w.x = cvt_pk_bf16(p1[sb][8], p1[sb][9]); w.y = cvt_pk_bf16(p1[sb][10], p1[sb][11]); w.z = cvt_pk_bf16(p1[sb][12], p1[sb][13]); w.w = cvt_pk_bf16(p1[sb][14], p1[sb][15]); pa[sb][3] = __builtin_bit_cast(bf16x8, w);
            }
#pragma unroll
            for (int sb = 0; sb < 2; ++sb)
                if (resc[sb]) {
#pragma unroll
                    for (int r = 0; r < 16; ++r) { const float fr_ = wsf[sb * 32 + crow(r, hi)]; o[sb][0][r] *= fr_; o[sb][1][r] *= fr_; } }
        }
        act_prev = act;
        ATT_BAR();
    }
    if (!grp) ATT_BAR();
    LAS bf16_t* stg = (LAS bf16_t*)(lds + LDS_OST) + wave * 2048;
#pragma unroll
    for (int sb = 0; sb < 2; ++sb) {
        float ls = l[sb]; ls += __shfl_xor(ls, 32);
        if (hi == 0) wsf[64 + sb * 32 + r32] = ls;
        float rli[16];
#pragma unroll
        for (int r = 0; r < 16; ++r) rli[r] = __builtin_amdgcn_rcpf(wsf[64 + sb * 32 + crow(r, hi)]);
#pragma unroll
        for (int r = 0; r < 16; ++r) { const int orow = crow(r, hi);
#pragma unroll
            for (int d0 = 0; d0 < 2; ++d0) stg[orow * 64 + d0 * 32 + r32] = (bf16_t)f2bf(o[sb][d0][r] * rli[r]); }
        bf16_t* Ow = F.o() + (size_t)(b * SEQ + s + half * 64 + sb * 32) * 1024 + head * 64;
#pragma unroll
        for (int i = 0; i < 4; ++i) { const int row = i * 8 + (lane >> 3), ch = lane & 7; const u32x4 v = *(const LAS u32x4*)(stg + row * 64 + ch * 8); *(u32x4*)(Ow + (size_t)row * 1024 + ch * 8) = v; }
    }
#undef ATT_DMA
}
#undef ATT_WAIT_BAR
#undef ATT_BAR
}
__device__ __forceinline__ void phase_attn_fast(Frame& F) {
    for (int u = blockIdx.x; u < NBATCH * 4 * 16; u += F.G) att::attn_unit<0>(F, u >> 6, (u >> 4) & 3, u & 15);
}
template <int MODE> __device__ __forceinline__ void phase_attn_probe(Frame& F) {
    for (int u = blockIdx.x; u < NBATCH * 4 * 16; u += F.G) att::attn_unit<MODE>(F, u >> 6, (u >> 4) & 3, u & 15);
}


struct EpiPlain4096 {
    static constexpr bool PERM = true;
    bf16_t* O;
    __device__ __forceinline__ void operator()(const f32x4 (&acc)[2][2][4][2], const pg8::Unit& u, int wr, int wc, int fr, int fq) const {
        const int row0 = u.pm * 256 + wr * 64 + fr, col0 = u.pn * 256 + wc * 32 + 8 * fq;
#pragma unroll
        for (int ai = 0; ai < 2; ++ai)
#pragma unroll
            for (int m = 0; m < 4; ++m) { bf16_t* rowp = O + (size_t)(row0 + ai * 128 + m * 16) * 4096 + col0;
#pragma unroll
                for (int bj = 0; bj < 2; ++bj) { const f32x4 v0 = acc[ai][bj][m][0], v1 = acc[ai][bj][m][1]; u32x4 w;
                    w.x = cvt_pk_bf16(v0[0], v0[1]); w.y = cvt_pk_bf16(v0[2], v0[3]); w.z = cvt_pk_bf16(v1[0], v1[1]); w.w = cvt_pk_bf16(v1[2], v1[3]);
                    *(u32x4*)(rowp + bj * 128) = w; } }
    }
};
__device__ __forceinline__ void phase_gemm1_plain(Frame& F) {
    pg8::Gemm g{F.h(), F.win(), 2 * D, 2 * D, 2 * D, 0}; pg8::StaticOrder S; S.init(NT, 4096, F.G, (int)blockIdx.x);
    EpiPlain4096 E{F.u()};
    pg8::gemm_phase<EpiPlain4096, pg8::StaticOrder, false, false, true>(F.lds, g, S, E, nullptr);
}
__device__ __forceinline__ int moe_first_idle(Frame& F, int l) { const unsigned* cnt = F.ctl() + CW_CNT + 16 * l; int t = 0; for (int e = 0; e < 16; ++e) t += ((int)cnt[e] + 255) >> 8; return (4 * t) % F.G; }
constexpr int N_PHASES = 19;
__global__ void __launch_bounds__(NTHREADS, 2) fwd_kernel(Params args) {
    extern __shared__ __attribute__((aligned(16))) unsigned char lds_raw[];
    Frame F;
    F.in = args.in; F.out = args.out; F.ws = args.ws; F.lds = (LAS unsigned char*)lds_raw;
    F.tid = threadIdx.x; F.lane = F.tid & 63; F.wave = __builtin_amdgcn_readfirstlane(F.tid >> 6); F.G = gridDim.x;
    for (int u = F.tid; u < (LDS_BYTES - LDSCTL_OFF) / 4; u += NTHREADS) ((LAS unsigned*)(F.lds + LDSCTL_OFF))[u] = 0u;
    __syncthreads();
    XcdBarrier bar; bar.bar = F.ctl() + CW_BAR; bar.x = 0; bar.st = nullptr;
    if (MK_N_LAUNCHES == 1) bar = xcd_barrier_post(F.ctl() + CW_BAR, (volatile LAS unsigned*)(F.lds + MISC_OFF) + 8);
    const int lo = args.ph_lo, hi = args.ph_hi;
#define IN(k) (lo <= (k) && (k) < hi)
#define SEAM(k) do { if (IN(k) && IN((k) + 1)) xcd_barrier(bar); } while (0)
#ifndef PROBE_PHASE
#define PROBE_PHASE -1
#endif
#ifndef PROBE_REPS
#define PROBE_REPS 1
#endif
#define REP(k) for (int _rep = 0; _rep < ((k) == PROBE_PHASE ? PROBE_REPS : 1); ++_rep, ((k) == PROBE_PHASE && _rep < PROBE_REPS ? xcd_barrier(bar) : (void)0))
    if (IN(0)) REP(0) { phase_prologue(F); } SEAM(0);
    if (IN(1)) REP(1) { phase_norm1_l0(F); } SEAM(1);
    if (IN(2)) REP(2) { if (FAST_MIX) phase_gemm1_fast(F); else phase_gemm1_naive(F); filler_static(F, 0, (72 * 16) % F.G); } SEAM(2);
    if (!FAST_MIX) { if (IN(3)) { phase_vsq_naive(F); } SEAM(3); }
    if (!FAST_MIX) { if (IN(4)) { phase_vnorm_naive(F); } SEAM(4); }
    if (IN(5)) REP(5) { if (FAST_MIX) phase_sgu_fast(F); else phase_sgu_naive(F); } SEAM(5);
    if (IN(6)) REP(6) { if (FAST_G2) phase_gemm2_fast(F); else phase_gemm2_naive(F); filler_static(F, 1, F.G == 256 ? 64 : (72 * 4) % F.G); } SEAM(6);
    if (IN(7)) REP(7) { phase_norm2_route(F, 0, NT); } SEAM(7);
    if (IN(8)) REP(8) { if (FAST_GU) phase_gateup_fast(F, 0); else phase_gateup_naive(F, 0); filler_static(F, 2, moe_first_idle(F, 0)); } SEAM(8);
    if (IN(9)) REP(9) { if (FAST_DN) phase_down_fast(F, 0); else phase_down_naive(F, 0); filler_static(F, 3, moe_first_idle(F, 0)); } SEAM(9);
    if (IN(10)) REP(10) { phase_combine<false>(F, 0, NT); } SEAM(10);
    if (IN(11)) REP(11) { if (FAST_QKV) phase_qkv_fast(F); else phase_qkv_naive(F); filler_static(F, 4, 400 % F.G); } SEAM(11);
    if (!FAST_QKV) { if (IN(12)) { phase_rope_naive(F); } SEAM(12); }
    if (IN(13)) REP(13) { if (FAST_ATTN) phase_attn_fast(F); else phase_attn_naive(F); } SEAM(13);
    if (IN(14)) REP(14) { if (FAST_WO) phase_wo_fast(F); else phase_wo_naive(F); } SEAM(14);
    if (IN(15)) REP(15) { phase_norm2_route(F, 1, NX); } SEAM(15);
    if (IN(16)) REP(16) { if (FAST_GU) phase_gateup_fast(F, 1); else phase_gateup_naive(F, 1); } SEAM(16);
    if (IN(17)) REP(17) { if (FAST_DN) phase_down_fast(F, 1); else phase_down_naive(F, 1); } SEAM(17);
    if (IN(18)) REP(18) { phase_combine<true>(F, 1, NX); }
#ifndef PROBE_TAIL
#define PROBE_TAIL 0
#endif
    if (PROBE_TAIL != 0) {
        xcd_barrier(bar);
        Frame F2 = F; F2.out = (float*)(args.ws + WS_OV + 80 * MiB);
        if (PROBE_TAIL == 7) { phase_norm2_route(F, 0, NT); xcd_barrier(bar); phase_norm2_route(F, 0, NT); xcd_barrier(bar); }
        if (PROBE_TAIL == 10) { phase_combine<false>(F2, 0, NT); xcd_barrier(bar); phase_combine<false>(F2, 0, NT); xcd_barrier(bar); }
        if (PROBE_TAIL == 14) { phase_wo_fast(F2); xcd_barrier(bar); phase_wo_fast(F2); xcd_barrier(bar); }
        if (PROBE_TAIL == 1) { phase_norm1_l0(F); xcd_barrier(bar); phase_norm1_l0(F); xcd_barrier(bar); }
        if (PROBE_TAIL == 2) { phase_gemm1_fast(F); xcd_barrier(bar); phase_gemm1_fast(F); xcd_barrier(bar); }
        if (PROBE_TAIL == 22) { phase_gemm1_plain(F); xcd_barrier(bar); phase_gemm1_plain(F); xcd_barrier(bar); }
        if (PROBE_TAIL == 130) { phase_attn_probe<0>(F); xcd_barrier(bar); phase_attn_probe<0>(F); xcd_barrier(bar); }
        if (PROBE_TAIL == 131) { phase_attn_probe<1>(F); xcd_barrier(bar); phase_attn_probe<1>(F); xcd_barrier(bar); }
        if (PROBE_TAIL == 132) { phase_attn_probe<2>(F); xcd_barrier(bar); phase_attn_probe<2>(F); xcd_barrier(bar); }
        if (PROBE_TAIL == 50) { phase_prologue(F); xcd_barrier(bar); phase_prologue(F); xcd_barrier(bar); }
        if (PROBE_TAIL == 5) { phase_sgu_fast(F); xcd_barrier(bar); phase_sgu_fast(F); xcd_barrier(bar); }
        if (PROBE_TAIL == 6) { phase_gemm2_fast(F); xcd_barrier(bar); phase_gemm2_fast(F); xcd_barrier(bar); }
        if (PROBE_TAIL == 8) { phase_gateup_fast(F, 0); xcd_barrier(bar); phase_gateup_fast(F, 0); xcd_barrier(bar); }
        if (PROBE_TAIL == 9) { phase_down_fast(F, 0); xcd_barrier(bar); phase_down_fast(F, 0); xcd_barrier(bar); }
        if (PROBE_TAIL == 11) { phase_qkv_fast(F); xcd_barrier(bar); phase_qkv_fast(F); xcd_barrier(bar); }
        if (PROBE_TAIL == 71) { phase_norm2_route_t<1>(F, 0, NT); xcd_barrier(bar); phase_norm2_route_t<1>(F, 0, NT); xcd_barrier(bar); }
        if (PROBE_TAIL == 72) { phase_norm2_route_t<2>(F, 0, NT); xcd_barrier(bar); phase_norm2_route_t<2>(F, 0, NT); xcd_barrier(bar); }
        if (PROBE_TAIL == 73) { phase_norm2_route_t<3>(F, 0, NT); xcd_barrier(bar); phase_norm2_route_t<3>(F, 0, NT); xcd_barrier(bar); }
        if (PROBE_TAIL == 100) { for (int i = 0; i < 20; ++i) xcd_barrier(bar); }
    }
#undef IN
#undef SEAM
}
__global__ void zero_out_kernel(float* out, int n) { for (int i = blockIdx.x * blockDim.x + threadIdx.x; i < n; i += gridDim.x * blockDim.x) out[i] = 0.f; }

extern "C" void kernel_launch(void* const* d_in, const int* in_sizes, int n_in, void* d_out, int out_size, void* d_ws, size_t ws_size, hipStream_t stream) {
    static int grid = 0;
    if (grid == 0) {
        int dev = 0, cus = 0, per_cu = 0;
        (void)hipGetDevice(&dev); (void)hipDeviceGetAttribute(&cus, hipDeviceAttributeMultiprocessorCount, dev);
        if (hipFuncSetAttribute((const void*)fwd_kernel, hipFuncAttributeMaxDynamicSharedMemorySize, LDS_BYTES) != hipSuccess) { fprintf(stderr, "kernel_launch: hipFuncSetAttribute failed\n"); }
        (void)hipOccupancyMaxActiveBlocksPerMultiprocessor(&per_cu, (const void*)fwd_kernel, NTHREADS, LDS_BYTES);
        (void)hipGetLastError();
        if (per_cu < 1) per_cu = 1;
        grid = cus > 0 ? cus : 256;
        fprintf(stderr, "kernel_launch: cus %d per_cu %d grid %d ws %zu need %zu\n", cus, per_cu, grid, ws_size, (size_t)WS_END);
    }
    if (n_in != 22 || ws_size < WS_END || out_size != NX * D) {
        zero_out_kernel<<<256, 256, 0, stream>>>((float*)d_out, out_size);
        return;
    }
    (void)hipMemsetAsync((char*)d_ws + WS_CTL, 0, CTL_ZERO_BYTES, stream);
    Params a{};
    for (int i = 0; i < 22; ++i) a.in[i] = (const float*)d_in[i];
    a.out = (float*)d_out; a.ws = (unsigned char*)d_ws;
    if (MK_N_LAUNCHES == 1) {
        a.ph_lo = 0; a.ph_hi = N_PHASES;
        void* kargs[] = {&a};
        (void)hipLaunchCooperativeKernel((const void*)fwd_kernel, dim3(grid), dim3(NTHREADS), kargs, LDS_BYTES, stream);
    } else {
        for (int ph = 0; ph < N_PHASES; ++ph) { a.ph_lo = ph; a.ph_hi = ph + 1; hipLaunchKernelGGL(fwd_kernel, dim3(grid), dim3(NTHREADS), LDS_BYTES, stream, a); }
    }
}
```

```cpp
#include <hip/hip_runtime.h>
#include <cstdint>
#include <cstdio>

#define LAS __attribute__((address_space(3)))
typedef unsigned short bf16_t;
typedef short bf16x8 __attribute__((ext_vector_type(8)));
typedef float f32x4 __attribute__((ext_vector_type(4)));
typedef float f32x2 __attribute__((ext_vector_type(2)));
typedef unsigned u32x4 __attribute__((ext_vector_type(4)));
typedef unsigned u32x2 __attribute__((ext_vector_type(2)));

#ifndef FAST_GEMM
#define FAST_GEMM 1
#endif
#ifndef FAST_ATTN
#define FAST_ATTN 1
#endif
#ifndef FAST_MIX
#define FAST_MIX FAST_GEMM
#endif
constexpr int U_LD = FAST_MIX ? 4096 : 2048;
#ifndef FAST_G2
#define FAST_G2 FAST_GEMM
#endif
#ifndef FAST_GU
#define FAST_GU FAST_GEMM
#endif
#ifndef FAST_DN
#define FAST_DN FAST_GEMM
#endif
#ifndef FAST_QKV
#define FAST_QKV FAST_GEMM
#endif
#ifndef FAST_WO
#define FAST_WO FAST_GEMM
#endif
#ifndef MK_N_LAUNCHES
#define MK_N_LAUNCHES 1
#endif

constexpr int D = 1024, NBATCH = 8, SEQ = 2048, NX = NBATCH * SEQ, CTXL = 256, NCX = NBATCH * CTXL, NT = NX + NCX;
constexpr int AW = 2048, CHUNK = 128, NGRP = 8, GW = 256;
constexpr int NE = 16, DE = 512;
constexpr int NQKV = 1536, KVD = 256, HD = 64;
constexpr float EPS = 1e-6f;
constexpr float LOG2E = 1.4426950408889634f;
constexpr float QSCALE = 0.125f * LOG2E;
constexpr int NTHREADS = 512, NWAVES = 8;
constexpr int LDS_BYTES = 163840;
constexpr int MISC_OFF = 131072 + 320;
constexpr int LDSCTL_OFF = 131072;

constexpr size_t MiB = 1u << 20;
constexpr size_t WS_CTL = 0, CTL_ZERO_BYTES = 128 * 1024;
constexpr size_t WS_MODP = 1 * MiB;
constexpr size_t WS_MODF = 3 * MiB;
constexpr size_t WS_TOKE = 4 * MiB;
constexpr size_t WS_TOKP = 4 * MiB + 256 * 1024;
constexpr size_t WS_TOKW = 4 * MiB + 512 * 1024;
constexpr size_t WS_LIST = 5 * MiB;
constexpr size_t WS_VSQ = 7 * MiB;
constexpr size_t WS_HS = 9 * MiB + 512 * 1024;
constexpr size_t WS_WSBF = 10 * MiB;
constexpr size_t WS_WIN = 11 * MiB;
constexpr size_t WS_WOUT = 19 * MiB;
constexpr size_t WS_WQKV = 23 * MiB;
constexpr size_t WS_WO = 26 * MiB;
constexpr size_t WS_GU = 28 * MiB;
constexpr size_t WS_DN = 92 * MiB;
constexpr size_t WS_H = 124 * MiB;
constexpr size_t WS_XBH = 160 * MiB;
constexpr size_t WS_OV = 196 * MiB;
constexpr size_t WS_U = WS_OV;
constexpr size_t WS_VT = WS_OV + 72 * MiB;
constexpr size_t WS_HID = WS_OV;
constexpr size_t WS_Y = WS_OV + 40 * MiB;
constexpr size_t WS_Q = WS_OV;
constexpr size_t WS_K = WS_OV + 32 * MiB;
constexpr size_t WS_V = WS_OV + 41 * MiB;
constexpr size_t WS_O = WS_OV + 50 * MiB;
constexpr size_t WS_END = WS_OV + 144 * MiB;
constexpr int CW_CNT = 64;
constexpr int CW_FILL = 1024;
constexpr int CW_AMAX_IN = 32768, CW_AMAX_QKV = CW_AMAX_IN + 4096, CW_AMAX_GU = CW_AMAX_QKV + 1536;
constexpr int CW_BAR = 4096;
constexpr int CW_RDYO = 8192 + 2 * 160 * 64;
constexpr int CW_RDY = 8192;

__device__ __forceinline__ float bf2f(bf16_t v) { return __uint_as_float((unsigned)v << 16); }
__device__ __forceinline__ unsigned f2bf(float f) { unsigned u = __float_as_uint(f); return (u + 0x7fffu + ((u >> 16) & 1u)) >> 16; }
__device__ __forceinline__ unsigned pk2(float lo, float hi) { return f2bf(lo) | (f2bf(hi) << 16); }
__device__ __forceinline__ float wave_sum(float v) {
#pragma unroll
    for (int o = 1; o < 64; o <<= 1) v += __shfl_xor(v, o);
    return v;
}
__device__ __forceinline__ float wave_sum_dpp(float v) {
    v += __builtin_bit_cast(float, __builtin_amdgcn_update_dpp(0, __builtin_bit_cast(int, v), 0xB1, 0xf, 0xf, true));
    v += __builtin_bit_cast(float, __builtin_amdgcn_update_dpp(0, __builtin_bit_cast(int, v), 0x4E, 0xf, 0xf, true));
    v += __builtin_bit_cast(float, __builtin_amdgcn_update_dpp(0, __builtin_bit_cast(int, v), 0x141, 0xf, 0xf, true));
    v += __builtin_bit_cast(float, __builtin_amdgcn_update_dpp(0, __builtin_bit_cast(int, v), 0x140, 0xf, 0xf, true));
    v += __builtin_bit_cast(float, __builtin_amdgcn_update_dpp(0, __builtin_bit_cast(int, v), 0x142, 0xa, 0xf, false));
    v += __builtin_bit_cast(float, __builtin_amdgcn_update_dpp(0, __builtin_bit_cast(int, v), 0x143, 0xc, 0xf, false));
    return __builtin_bit_cast(float, __builtin_amdgcn_readlane(__builtin_bit_cast(int, v), 63));
}
__device__ __forceinline__ float wave_max_dpp(float v) {
    v = fmaxf(v, __builtin_bit_cast(float, __builtin_amdgcn_update_dpp(0, __builtin_bit_cast(int, v), 0xB1, 0xf, 0xf, true)));
    v = fmaxf(v, __builtin_bit_cast(float, __builtin_amdgcn_update_dpp(0, __builtin_bit_cast(int, v), 0x4E, 0xf, 0xf, true)));
    v = fmaxf(v, __builtin_bit_cast(float, __builtin_amdgcn_update_dpp(0, __builtin_bit_cast(int, v), 0x141, 0xf, 0xf, true)));
    v = fmaxf(v, __builtin_bit_cast(float, __builtin_amdgcn_update_dpp(0, __builtin_bit_cast(int, v), 0x140, 0xf, 0xf, true)));
    v = fmaxf(v, __builtin_bit_cast(float, __builtin_amdgcn_update_dpp(0, __builtin_bit_cast(int, v), 0x142, 0xa, 0xf, false)));
    v = fmaxf(v, __builtin_bit_cast(float, __builtin_amdgcn_update_dpp(0, __builtin_bit_cast(int, v), 0x143, 0xc, 0xf, false)));
    return __builtin_bit_cast(float, __builtin_amdgcn_readlane(__builtin_bit_cast(int, v), 63));
}
__device__ __forceinline__ float gelu_tanh(float x) { const float t = x * __builtin_fmaf(x * x, -0.10294324f, -2.3022082f); return x * __builtin_amdgcn_rcpf(1.f + __builtin_amdgcn_exp2f(t)); }
__device__ __forceinline__ f32x2 gelu_tanh2(f32x2 x) { const f32x2 p = x * x * (f32x2){-0.10294324f, -0.10294324f} + (f32x2){-2.3022082f, -2.3022082f}; const f32x2 t = x * p;
    const f32x2 d = (f32x2){__builtin_amdgcn_exp2f(t.x), __builtin_amdgcn_exp2f(t.y)} + (f32x2){1.f, 1.f}; return x * (f32x2){__builtin_amdgcn_rcpf(d.x), __builtin_amdgcn_rcpf(d.y)}; }
__device__ __forceinline__ float silu_f(float x) { return x * __builtin_amdgcn_rcpf(1.f + __builtin_amdgcn_exp2f(-1.4426950408889634f * x)); }
__device__ __forceinline__ float sigmoid_f(float x) { return __builtin_amdgcn_rcpf(1.f + __builtin_amdgcn_exp2f(-1.4426950408889634f * x)); }

typedef __amdgpu_buffer_rsrc_t rsrc_t;
__device__ __forceinline__ void st16_wt(const unsigned char* ws, const void* p, u32x4 v) {
    __builtin_amdgcn_raw_buffer_store_b128(v, __builtin_amdgcn_make_buffer_rsrc((void*)ws, 0, 0x7fffffff, 0x00020000), (unsigned)((const unsigned char*)p - ws), 0, 16); }
#define XB_TMO      128
#define XB_XCNT(j)  (256  + 64 * (j))
#define XB_XSUB(j)  (1280 + 64 * (j))
#define XB_XGEN(j)  (2304 + 64 * (j))
#define XB_TOP      3328
#define XB_TOPGEN   3392
#define XCD_BAR_WORDS 3456
#define XB_SPIN_CAP (1u << 22)
__device__ __forceinline__ unsigned xb_ld(unsigned* p)              { return __hip_atomic_load(p, __ATOMIC_RELAXED, __HIP_MEMORY_SCOPE_AGENT); }
__device__ __forceinline__ unsigned xb_add(unsigned* p, unsigned v) { return __hip_atomic_fetch_add(p, v, __ATOMIC_RELAXED, __HIP_MEMORY_SCOPE_AGENT); }
__device__ __forceinline__ unsigned xb_xcc_id() { return (unsigned)__builtin_amdgcn_s_getreg((3 << 11) | 20) & 0xFu; }
#define XB_SPIN(cond, bar) do { unsigned _sp = 0; while (cond) { __builtin_amdgcn_s_sleep(1); \
    if ((++_sp & 255u) == 0u) { if (xb_ld(&(bar)[XB_TMO])) break; if (_sp > XB_SPIN_CAP) { atomicAdd(&(bar)[XB_TMO], 1u); break; } } } } while (0)
struct XcdBarrier { unsigned* bar; unsigned x; volatile LAS unsigned* st; };
__device__ __forceinline__ XcdBarrier xcd_barrier_post(unsigned* bar, volatile LAS unsigned* st) {
    XcdBarrier b; b.bar = bar; b.x = xb_xcc_id(); b.st = st;
    if (threadIdx.x == 0) (void)xb_add(&bar[XB_XCNT(b.x)], 1u);
    return b;
}
__device__ __forceinline__ void xcd_barrier_complete(unsigned* bar, unsigned x, unsigned& nloc, unsigned& nx) {
    const unsigned G = gridDim.x * gridDim.y * gridDim.z;
    unsigned sum, cnt, mine, sp = 0u;
    for (;;) {
        sum = 0u; cnt = 0u; mine = 0u;
#pragma unroll
        for (unsigned j = 0; j < 16; ++j) { const unsigned c = xb_ld(&bar[XB_XCNT(j)]); sum += c; cnt += (c > 0u) ? 1u : 0u; mine = (j == x) ? c : mine; }
        if (sum == G) break;
        __builtin_amdgcn_s_sleep(1);
        if ((++sp & 255u) == 0u) { if (xb_ld(&bar[XB_TMO])) break; if (sp > XB_SPIN_CAP) { atomicAdd(&bar[XB_TMO], 1u); break; } }
    }
    nloc = mine > 0u ? mine : 1u; nx = cnt > 0u ? cnt : 1u;
}
struct NoPro { __device__ __forceinline__ void operator()() const {} };
template <class Pro = NoPro> __device__ __forceinline__ void xcd_barrier(const XcdBarrier& b, const Pro& pro = Pro()) {
    asm volatile("s_waitcnt vmcnt(0)" ::: "memory");
    __syncthreads();
    if (threadIdx.x >= 64) pro();
    if (threadIdx.x == 0) {
        unsigned* bar = b.bar;
        __builtin_amdgcn_s_waitcnt(0);
        unsigned nloc = b.st[0], nx = b.st[1];
        if (nloc == 0u) { xcd_barrier_complete(bar, b.x, nloc, nx); b.st[0] = nloc; b.st[1] = nx; }
        const unsigned old = xb_add(&bar[XB_XSUB(b.x)], 1u);
        const unsigned gen = old / nloc;
        if (old + 1u == (gen + 1u) * nloc) {
            __builtin_amdgcn_fence(__ATOMIC_ACQUIRE, "agent");
            __builtin_amdgcn_fence(__ATOMIC_RELEASE, "agent");
            asm volatile("s_waitcnt vmcnt(0)" ::: "memory");
            const unsigned og = xb_add(&bar[XB_TOP], 1u);
            const unsigned tg = og / nx;
            if (og + 1u == (tg + 1u) * nx) xb_add(&bar[XB_TOPGEN], 1u);
            else XB_SPIN(xb_ld(&bar[XB_TOPGEN]) == tg, bar);
            xb_add(&bar[XB_XGEN(b.x)], 1u);
            asm volatile("s_waitcnt vmcnt(0)" ::: "memory");
        } else {
            __builtin_amdgcn_fence(__ATOMIC_ACQUIRE, "agent");
            XB_SPIN(xb_ld(&bar[XB_XGEN(b.x)]) == gen, bar);
            asm volatile("s_waitcnt vmcnt(0)" ::: "memory");
        }
    }
    __syncthreads();
}

struct Params { const float* in[22]; float* out; unsigned char* ws; int ph_lo, ph_hi; };
enum { I_X = 0, I_C, I_CTX, I_CCTX, I_ADAW, I_ADAB, I_N1G, I_N2G, I_AWIN, I_AGV, I_AWS, I_ABS, I_AWOUT, I_BQKV, I_BSINK, I_BWO, I_RW, I_RB, I_MG, I_MU, I_MD, I_FG };

struct Frame {
    const float* const* in; float* out; unsigned char* ws;
    LAS unsigned char* lds;
    int tid, lane, wave, G;
    __device__ __forceinline__ unsigned* ctl() const { return (unsigned*)(ws + WS_CTL); }
    __device__ __forceinline__ float* modp() const { return (float*)(ws + WS_MODP); }
    __device__ __forceinline__ float* modf() const { return (float*)(ws + WS_MODF); }
    __device__ __forceinline__ int* toke() const { return (int*)(ws + WS_TOKE); }
    __device__ __forceinline__ int* tokp() const { return (int*)(ws + WS_TOKP); }
    __device__ __forceinline__ float* tokw() const { return (float*)(ws + WS_TOKW); }
    __device__ __forceinline__ int* list() const { return (int*)(ws + WS_LIST); }
    __device__ __forceinline__ float* vsq() const { return (float*)(ws + WS_VSQ); }
    __device__ __forceinline__ bf16_t* wsbf() const { return (bf16_t*)(ws + WS_WSBF); }
    __device__ __forceinline__ bf16_t* win() const { return (bf16_t*)(ws + WS_WIN); }
    __device__ __forceinline__ bf16_t* wout() const { return (bf16_t*)(ws + WS_WOUT); }
    __device__ __forceinline__ bf16_t* wqkv() const { return (bf16_t*)(ws + WS_WQKV); }
    __device__ __forceinline__ bf16_t* wo() const { return (bf16_t*)(ws + WS_WO); }
    __device__ __forceinline__ bf16_t* gu() const { return (bf16_t*)(ws + WS_GU); }
    __device__ __forceinline__ bf16_t* dn() const { return (bf16_t*)(ws + WS_DN); }
    __device__ __forceinline__ bf16_t* h() const { return (bf16_t*)(ws + WS_H); }
    __device__ __forceinline__ signed char* hq() const { return (signed char*)(ws + WS_H); }
    __device__ __forceinline__ float* hs() const { return (float*)(ws + WS_HS); }
    __device__ __forceinline__ bf16_t* cxp() const { return (bf16_t*)(ws + WS_H + 18 * MiB); }
    __device__ __forceinline__ signed char* winq() const { return (signed char*)(ws + WS_WIN); }
    __device__ __forceinline__ unsigned* amax_in() const { return ctl() + CW_AMAX_IN; }
    __device__ __forceinline__ unsigned* amax_qkv() const { return ctl() + CW_AMAX_QKV; }
    __device__ __forceinline__ unsigned* amax_gu() const { return ctl() + CW_AMAX_GU; }
    __device__ __forceinline__ signed char* wqkvq() const { return (signed char*)(ws + WS_WQKV); }
    __device__ __forceinline__ signed char* guq() const { return (signed char*)(ws + WS_GU); }
    __device__ __forceinline__ bf16_t* xbh() const { return (bf16_t*)(ws + WS_XBH); }
    __device__ __forceinline__ bf16_t* u() const { return (bf16_t*)(ws + WS_U); }
    __device__ __forceinline__ bf16_t* vt() const { return (bf16_t*)(ws + WS_VT); }
    __device__ __forceinline__ bf16_t* hid() const { return (bf16_t*)(ws + WS_HID); }
    __device__ __forceinline__ bf16_t* y() const { return (bf16_t*)(ws + WS_Y); }
    __device__ __forceinline__ bf16_t* q() const { return (bf16_t*)(ws + WS_Q); }
    __device__ __forceinline__ bf16_t* k() const { return (bf16_t*)(ws + WS_K); }
    __device__ __forceinline__ bf16_t* v() const { return (bf16_t*)(ws + WS_V); }
    __device__ __forceinline__ bf16_t* o() const { return (bf16_t*)(ws + WS_O); }
};

__device__ __forceinline__ bf16_t* xb_row(const Frame& F, int row) { return F.xbh() + (size_t)row * D; }
__device__ __forceinline__ const float* xin_row(const Frame& F, int row) { return row < NX ? F.in[I_X] + (size_t)row * D : F.in[I_CTX] + (size_t)(row - NX) * D; }
__device__ __forceinline__ float mod_from_partials(const Frame& F, int l, int r, int n) {
    float s = F.in[I_ADAB][l * 6144 + n];
#pragma unroll
    for (int kc = 0; kc < 4; ++kc) s += F.modp()[(size_t)((kc * 2 + l) * 9 + r) * 6144 + n];
    return s;
}

__device__ __forceinline__ void transpose_item(const float* W, int ldw, int k0, int n0, bf16_t* WT, int ldo, int out_row0, LAS float* scr, int lane) {
    f32x4 ld[8];
#pragma unroll
    for (int i = 0; i < 8; ++i) ld[i] = *(const f32x4*)(W + (size_t)(k0 + 8 * i + (lane >> 3)) * ldw + n0 + 4 * (lane & 7));
#pragma unroll
    for (int i = 0; i < 8; ++i) { LAS float* d = scr + (8 * i + (lane >> 3)) * 33 + 4 * (lane & 7); d[0] = ld[i].x; d[1] = ld[i].y; d[2] = ld[i].z; d[3] = ld[i].w; }
    asm volatile("s_waitcnt lgkmcnt(0)" ::: "memory");
    const int c = lane & 7;
#pragma unroll
    for (int j = 0; j < 4; ++j) { const int n = (lane >> 3) + 8 * j; const LAS float* s = scr + (8 * c) * 33 + n;
        u32x4 o; o.x = pk2(s[0 * 33], s[1 * 33]); o.y = pk2(s[2 * 33], s[3 * 33]); o.z = pk2(s[4 * 33], s[5 * 33]); o.w = pk2(s[6 * 33], s[7 * 33]);
        *(u32x4*)(WT + (size_t)(out_row0 + n) * ldo + k0 + 8 * c) = o; }
    asm volatile("s_waitcnt lgkmcnt(0)" ::: "memory");
}

__device__ __forceinline__ void absmax_item(const float* W, int ldw, int k0, int n0, unsigned* amax, int lane, int gu = -1) {
    f32x4 mx = (f32x4){0.f, 0.f, 0.f, 0.f};
#pragma unroll 8
    for (int i = 0; i < 64; ++i) { const f32x4 w = *(const f32x4*)(W + (size_t)(k0 + i) * ldw + n0 + 4 * lane);
        mx.x = fmaxf(mx.x, fabsf(w.x)); mx.y = fmaxf(mx.y, fabsf(w.y)); mx.z = fmaxf(mx.z, fabsf(w.z)); mx.w = fmaxf(mx.w, fabsf(w.w)); }
    const int c = n0 + 4 * lane; unsigned* a = amax + (gu < 0 ? c : ((c >> 7) * 256 + (c & 127) + 128 * gu));
    atomicMax(a, __float_as_uint(mx.x)); atomicMax(a + 1, __float_as_uint(mx.y)); atomicMax(a + 2, __float_as_uint(mx.z)); atomicMax(a + 3, __float_as_uint(mx.w));
}
__device__ __forceinline__ void quant_item(const float* W, int ldw, int k0, int n0, signed char* WQ, int ldo, int out_row0, const unsigned* amax, LAS float* scr, int lane) {
    f32x4 ld[8];
#pragma unroll
    for (int i = 0; i < 8; ++i) ld[i] = *(const f32x4*)(W + (size_t)(k0 + 8 * i + (lane >> 3)) * ldw + n0 + 4 * (lane & 7));
#pragma unroll
    for (int i = 0; i < 8; ++i) { LAS float* d = scr + (8 * i + (lane >> 3)) * 33 + 4 * (lane & 7); d[0] = ld[i].x; d[1] = ld[i].y; d[2] = ld[i].z; d[3] = ld[i].w; }
    asm volatile("s_waitcnt lgkmcnt(0)" ::: "memory");
    const int n = lane & 31, kh = lane >> 5;
    const float am = __uint_as_float(amax[out_row0 + n]); const float inv = am > 0.f ? 127.f / am : 0.f;
    const LAS float* sp = scr + (32 * kh) * 33 + n;
    unsigned w[8];
#pragma unroll
    for (int i = 0; i < 8; ++i) { const int q0 = __float2int_rn(sp[(4 * i) * 33] * inv), q1 = __float2int_rn(sp[(4 * i + 1) * 33] * inv), q2 = __float2int_rn(sp[(4 * i + 2) * 33] * inv), q3 = __float2int_rn(sp[(4 * i + 3) * 33] * inv);
        w[i] = (unsigned)(q0 & 0xff) | ((unsigned)(q1 & 0xff) << 8) | ((unsigned)(q2 & 0xff) << 16) | ((unsigned)(q3 & 0xff) << 24); }
    signed char* o = WQ + (size_t)(out_row0 + n) * ldo + k0 + 32 * kh;
    *(u32x4*)o = (u32x4){w[0], w[1], w[2], w[3]}; *(u32x4*)(o + 16) = (u32x4){w[4], w[5], w[6], w[7]};
    asm volatile("s_waitcnt lgkmcnt(0)" ::: "memory");
}
__device__ __forceinline__ void store_row_i8(signed char* row, float* scale, int lane, const f32x4 (&v)[4]) {
    float mx = 0.f;
#pragma unroll
    for (int j = 0; j < 4; ++j) mx = fmaxf(mx, fmaxf(fmaxf(fabsf(v[j].x), fabsf(v[j].y)), fmaxf(fabsf(v[j].z), fabsf(v[j].w))));
    mx = wave_max_dpp(mx);
    const float inv = mx > 0.f ? 127.f / mx : 0.f;
#pragma unroll
    for (int j = 0; j < 4; ++j) { const int q0 = __float2int_rn(v[j].x * inv), q1 = __float2int_rn(v[j].y * inv), q2 = __float2int_rn(v[j].z * inv), q3 = __float2int_rn(v[j].w * inv);
        *(unsigned*)(row + 4 * lane + 256 * j) = (unsigned)(q0 & 0xff) | ((unsigned)(q1 & 0xff) << 8) | ((unsigned)(q2 & 0xff) << 16) | ((unsigned)(q3 & 0xff) << 24); }
    if (lane == 0) *scale = mx * (1.f / 127.f);
}

__device__ __forceinline__ void quant_strip(Frame& F, const float* W, int ldw, int n0, signed char* WQ, int out_row0, unsigned* amax) {
    LAS float* T = (LAS float*)F.lds + F.wave * 4096; LAS float* cm = (LAS float*)(F.lds + 135168);
    const int lane = F.lane, w = F.wave, lr = lane >> 3, c4 = (lane & 7) * 4;
    f32x4 ld[16];
#pragma unroll
    for (int i = 0; i < 16; ++i) ld[i] = *(const f32x4*)(W + (size_t)(128 * w + 8 * i + lr) * ldw + n0 + c4);
    f32x4 mx = (f32x4){0.f, 0.f, 0.f, 0.f};
#pragma unroll
    for (int i = 0; i < 16; ++i) { const int kl = 8 * i + lr, sw = kl & 31; LAS float* d = T + kl * 32;
        d[(c4 + 0) ^ sw] = ld[i].x; d[(c4 + 1) ^ sw] = ld[i].y; d[(c4 + 2) ^ sw] = ld[i].z; d[(c4 + 3) ^ sw] = ld[i].w;
        mx.x = fmaxf(mx.x, fabsf(ld[i].x)); mx.y = fmaxf(mx.y, fabsf(ld[i].y)); mx.z = fmaxf(mx.z, fabsf(ld[i].z)); mx.w = fmaxf(mx.w, fabsf(ld[i].w)); }
#pragma unroll
    for (int o = 8; o < 64; o <<= 1) { mx.x = fmaxf(mx.x, __shfl_xor(mx.x, o)); mx.y = fmaxf(mx.y, __shfl_xor(mx.y, o)); mx.z = fmaxf(mx.z, __shfl_xor(mx.z, o)); mx.w = fmaxf(mx.w, __shfl_xor(mx.w, o)); }
    if (lane < 8) *(LAS f32x4*)(cm + w * 32 + c4) = mx;
    __syncthreads();
    const int n = lane & 31, h = lane >> 5;
    float am = cm[n];
#pragma unroll
    for (int ww = 1; ww < 8; ++ww) am = fmaxf(am, cm[ww * 32 + n]);
    const float inv = am > 0.f ? 127.f / am : 0.f;
    signed char* o = WQ + (size_t)(out_row0 + n) * 1024 + 128 * w + 64 * h;
#pragma unroll
    for (int i16 = 0; i16 < 4; ++i16) { unsigned wd[4];
#pragma unroll
        for (int i4 = 0; i4 < 4; ++i4) { const int kl = 64 * h + 16 * i16 + 4 * i4;
            const int q0 = __float2int_rn(T[(kl + 0) * 32 + (n ^ ((kl + 0) & 31))] * inv), q1 = __float2int_rn(T[(kl + 1) * 32 + (n ^ ((kl + 1) & 31))] * inv);
            const int q2 = __float2int_rn(T[(kl + 2) * 32 + (n ^ ((kl + 2) & 31))] * inv), q3 = __float2int_rn(T[(kl + 3) * 32 + (n ^ ((kl + 3) & 31))] * inv);
            wd[i4] = (unsigned)(q0 & 0xff) | ((unsigned)(q1 & 0xff) << 8) | ((unsigned)(q2 & 0xff) << 16) | ((unsigned)(q3 & 0xff) << 24); }
        *(u32x4*)(o + 16 * i16) = (u32x4){wd[0], wd[1], wd[2], wd[3]}; }
    if (w == 0 && lane < 32) amax[out_row0 + n] = __float_as_uint(am);
    __syncthreads();
}
__device__ __forceinline__ void quant_gu_strip(Frame& F, int le, int q) {
    const int up = q >> 4, n0 = (q & 15) * 32;
    quant_strip(F, F.in[up ? I_MU : I_MG] + (size_t)le * 1024 * 512, 512, n0, F.guq() + (size_t)le * 1024 * 1024, n0 + (n0 / 128) * 128 + up * 128, F.amax_gu() + le * 1024);
}
__device__ __forceinline__ void phase_prologue(Frame& F) {
    LAS float* sc = (LAS float*)F.lds;
    LAS float* red = sc + 9 * 1024;
    for (int i = F.tid; i < 9 * 1024; i += NTHREADS) { const float v = (i < 8192) ? F.in[I_C][i] : F.in[I_CCTX][i - 8192]; sc[i] = silu_f(v); }
    __syncthreads();
    for (int it = blockIdx.x; it < 192; it += F.G) {
        const int kc = it & 3, cb = (it >> 2) % 24, l = it / 96;
        const float* W = F.in[I_ADAW] + (size_t)l * 1024 * 6144 + cb * 256 + 4 * F.lane;
        const int k0 = kc * 256 + F.wave * 32;
        f32x4 acc[9];
#pragma unroll
        for (int r = 0; r < 9; ++r) acc[r] = (f32x4){0.f, 0.f, 0.f, 0.f};
#pragma unroll 8
        for (int i = 0; i < 32; ++i) { const int k = k0 + i; const f32x4 wv = *(const f32x4*)(W + (size_t)k * 6144);
#pragma unroll
            for (int r = 0; r < 9; ++r) acc[r] += sc[r * 1024 + k] * wv; }
#pragma unroll
        for (int r = 0; r < 9; ++r) *(LAS f32x4*)(red + (F.wave * 9 + r) * 256 + 4 * F.lane) = acc[r];
        __syncthreads();
        for (int idx = F.tid; idx < 2304; idx += NTHREADS) { const int r = idx >> 8, ci = idx & 255; float s = 0.f;
#pragma unroll
            for (int w = 0; w < 8; ++w) s += red[(w * 9 + r) * 256 + ci];
            F.modp()[(size_t)((kc * 2 + l) * 9 + r) * 6144 + cb * 256 + ci] = s; }
        __syncthreads();
    }
    __syncthreads();
    LAS float* scr = (LAS float*)(F.lds + F.wave * 16384);
    const int gw = blockIdx.x * NWAVES + F.wave, NGW = F.G * NWAVES;
    for (int i = blockIdx.x * NTHREADS + F.tid; i < 8 * 128 * 128; i += F.G * NTHREADS) F.wsbf()[i] = (bf16_t)f2bf(F.in[I_AWS][i]);
}
__device__ __forceinline__ void conv_dn_item(Frame& F, int le, int q, LAS float* scr) {
    const int kb = q / 32, nb = q % 32;
    transpose_item(F.in[I_MD] + (size_t)le * 512 * 1024, 1024, kb * 64, nb * 32, F.dn() + (size_t)le * 1024 * 512, 512, nb * 32, scr, F.lane);
}
__device__ __forceinline__ int filler_blocks(int seg) { return seg == 0 ? 48 : seg == 1 ? 512 : seg == 2 ? 200 : seg == 3 ? 312 : 0; }
__device__ __forceinline__ int filler_count(int seg) { return seg == 0 ? 3072 : seg == 1 ? 2560 : seg == 4 ? 4096 : 0; }
__device__ __forceinline__ void filler_block_item(Frame& F, int seg, int r) {
    if (seg == 0) quant_strip(F, F.in[I_BQKV], 1536, r * 32, F.wqkvq(), r * 32, F.amax_qkv());
    else if (seg == 1) quant_gu_strip(F, r >> 5, r & 31);
    else if (seg == 2) quant_gu_strip(F, 16 + (r >> 5), r & 31);
    else { const int q = r + 200; quant_gu_strip(F, 16 + (q >> 5), q & 31); }
}
__device__ __forceinline__ void filler_item(Frame& F, int seg, int r, LAS float* scr) {
    if (seg == 0) {
        if (r < 1024) { const int kb = r / 32, nb = r % 32; transpose_item(F.in[I_AWOUT], 1024, kb * 64, nb * 32, F.wout(), 2048, nb * 32, scr, F.lane); return; } r -= 1024;
        if (r < 512) { const int kb = r / 32, nb = r % 32; transpose_item(F.in[I_BWO], 1024, kb * 64, nb * 32, F.wo(), 1024, nb * 32, scr, F.lane); return; } r -= 512;
        conv_dn_item(F, r >> 8, r & 255, scr);
    } else if (seg == 1) { const int q = r + 1536; conv_dn_item(F, q >> 8, q & 255, scr);
    } else { conv_dn_item(F, 16 + (r >> 8), r & 255, scr); }
}
__device__ __forceinline__ void filler_static(Frame& F, int seg, int first_idle, int rot = 0) {
    LAS float* scr = (LAS float*)(F.lds + F.wave * 16384);
    if (first_idle >= F.G || first_idle < 0) first_idle = 0;
    const int cv = ((int)blockIdx.x - rot + F.G) % F.G;
    if (cv < first_idle) return;
    const int bi = cv - first_idle, nbi = F.G - first_idle, nbk = filler_blocks(seg);
    for (int r = bi; r < nbk; r += nbi) filler_block_item(F, seg, r);
    const int w = bi * NWAVES + F.wave, NW = nbi * NWAVES, n = filler_count(seg);
    for (int r = w; r < n; r += NW) filler_item(F, seg, r, scr);
}

__device__ __forceinline__ void load_row(const float* row, int lane, f32x4 (&v)[4]) {
#pragma unroll
    for (int j = 0; j < 4; ++j) v[j] = *(const f32x4*)(row + 4 * lane + 256 * j);
}
__device__ __forceinline__ void load_row_bf16(const bf16_t* row, int lane, f32x4 (&v)[4]) {
#pragma unroll
    for (int j = 0; j < 4; ++j) { const u32x2 w = *(const u32x2*)(row + 4 * lane + 256 * j);
        v[j] = (f32x4){__uint_as_float(w.x << 16), __uint_as_float(w.x & 0xffff0000u), __uint_as_float(w.y << 16), __uint_as_float(w.y & 0xffff0000u)}; }
}
__device__ __forceinline__ float row_sumsq(const f32x4 (&v)[4]) {
    float s = 0.f;
#pragma unroll
    for (int j = 0; j < 4; ++j) s += (v[j].x * v[j].x + v[j].y * v[j].y) + (v[j].z * v[j].z + v[j].w * v[j].w);
    return wave_sum_dpp(s);
}
__device__ __forceinline__ void store_row_bf16(bf16_t* row, int lane, const f32x4 (&v)[4]) {
#pragma unroll
    for (int j = 0; j < 4; ++j) { u32x2 o; o.x = pk2(v[j].x, v[j].y); o.y = pk2(v[j].z, v[j].w); *(u32x2*)(row + 4 * lane + 256 * j) = o; }
}
__device__ __forceinline__ void phase_norm1_l0(Frame& F) {
    for (int idx = blockIdx.x * NTHREADS + F.tid; idx < 2 * 9 * 6144; idx += F.G * NTHREADS) { const int l = idx / 55296, rem = idx % 55296; F.modf()[idx] = mod_from_partials(F, l, rem / 6144, rem % 6144); }
    for (int it = blockIdx.x; it < 128; it += F.G) quant_strip(F, F.in[I_AWIN], 4096, it * 32, F.winq(), it * 32, F.amax_in());
    LAS float* lmA = (LAS float*)F.lds; LAS float* lmB = lmA + 1024;
    const int per = (NT + F.G - 1) / F.G; const int r0 = blockIdx.x * per; int r1 = r0 + per; if (r1 > NT) r1 = NT;
    int lo = r0;
    while (lo < r1) {
        const int grp = lo / 2048; int hi = (grp + 1) * 2048; if (hi > r1) hi = r1;
        __syncthreads();
        for (int n = F.tid; n < 1024; n += NTHREADS) { lmA[n] = F.in[I_N1G][n] * (1.f + mod_from_partials(F, 0, grp, 1024 + n)); lmB[n] = mod_from_partials(F, 0, grp, n); }
        __syncthreads();
        int row = lo + F.wave; f32x4 vn[4];
        if (row < hi) load_row(xin_row(F, row), F.lane, vn);
        for (; row < hi; row += NWAVES) {
            f32x4 v[4];
#pragma unroll
            for (int j = 0; j < 4; ++j) v[j] = vn[j];
            if (row + NWAVES < hi) load_row(xin_row(F, row + NWAVES), F.lane, vn);
            const float rstd = rsqrtf(row_sumsq(v) * (1.f / D) + EPS);
#pragma unroll
            for (int j = 0; j < 4; ++j) { const int c = 4 * F.lane + 256 * j; v[j] = v[j] * rstd * *(const LAS f32x4*)(lmA + c) + *(const LAS f32x4*)(lmB + c); }
            store_row_i8(F.hq() + (size_t)row * D, F.hs() + row, F.lane, v);
        }
        lo = hi;
    }
}
template <int RMODE = 0> __device__ __forceinline__ void phase_norm2_route_t(Frame& F, int l, int nrows) {
    constexpr int HS_ = 1026;
    LAS float* Wr = (LAS float*)F.lds;
    LAS float* Ht = (LAS float*)(F.lds + 65536);
    LAS float* lmA = (LAS float*)(F.lds + 135168); LAS float* lmB = lmA + 1024;
    LAS float* Pp = lmB + 1024;
    LAS float* Lg = Pp + 2048;
    LAS unsigned* lcnt = (LAS unsigned*)(Lg + 96 * 16);
    LAS int* rec = (LAS int*)(lcnt + 32);
    unsigned* cnt = F.ctl() + CW_CNT + 16 * l;
    const int lane = F.lane, wave = F.wave;
    __syncthreads();
    f32x4 wreg[8];
#pragma unroll
    for (int i = 0; i < 8; ++i) wreg[i] = *(const f32x4*)(F.in[I_RW] + 4 * (F.tid + NTHREADS * i));
    bool wr_pending = true;
    if (F.tid < 32) lcnt[F.tid] = 0u;
    const int per = (nrows + F.G - 1) / F.G; const int r0 = blockIdx.x * per; int r1 = r0 + per; if (r1 > nrows) r1 = nrows;
    const bool remap = (nrows == NT) && (F.G == 256); const int bx = (int)blockIdx.x;
    auto phys = [&](int v) { return remap ? ((v - r0) < 64 ? 64 * bx + (v - r0) : NX + 8 * bx + (v - r0 - 64)) : v; };
    int lo = r0, pi = 0, prev_pb = -1, prev_hi = 0;
    auto reduce_prev = [&]() {
        if (prev_pb >= 0 && F.tid < 256 && prev_pb + (F.tid >> 4) < prev_hi) { const LAS float* pp = Pp; float s = 0.f;
#pragma unroll
            for (int w = 0; w < 8; ++w) s += pp[w * 256 + F.tid];
            Lg[(prev_pb - r0) * 16 + F.tid] = s; } };
    auto load_x1 = [&](int prow, bool cx, f32x4 (&v)[4]) {
        if (cx) { const float* c0 = F.in[I_CTX] + (size_t)(prow - NX) * D; const bf16_t* p0 = F.cxp() + (size_t)(prow - NX) * D; const bf16_t* p1 = p0 + (size_t)NCX * D; const float* g1 = F.modf() + (size_t)8 * 6144 + 2048;
#pragma unroll
            for (int j = 0; j < 4; ++j) { const int c = 4 * lane + 256 * j; const u32x2 a = *(const u32x2*)(p0 + c), b = *(const u32x2*)(p1 + c);
                const f32x4 ps = (f32x4){__uint_as_float(a.x << 16) + __uint_as_float(b.x << 16), __uint_as_float(a.x & 0xffff0000u) + __uint_as_float(b.x & 0xffff0000u), __uint_as_float(a.y << 16) + __uint_as_float(b.y << 16), __uint_as_float(a.y & 0xffff0000u) + __uint_as_float(b.y & 0xffff0000u)};
                v[j] = *(const f32x4*)(c0 + c) + *(const f32x4*)(g1 + c) * ps; } }
        else load_row_bf16(xb_row(F, prow), lane, v); };
    while (lo < r1) {
        const int grp = phys(lo) / 2048; int hi = remap ? (lo < r0 + 64 ? r0 + 64 : r1) : (grp + 1) * 2048; if (hi > r1) hi = r1;
        const bool ctxp = (l == 0) && (grp == 8);
        const float* mf = F.modf() + (size_t)(l * 9 + grp) * 6144;
        __syncthreads();
        for (int n = F.tid; n < 1024; n += NTHREADS) { lmA[n] = F.in[I_N2G][l * D + n] * (1.f + mf[4096 + n]); lmB[n] = mf[3072 + n]; }
        __syncthreads();
        f32x4 vn[2][4];
#pragma unroll
        for (int t = 0; t < 2; ++t) { const int r = lo + 8 * t + wave; load_x1(phys(r < hi ? r : lo), ctxp, vn[t]); }
        for (int pb = lo; pb < hi; pb += 16) {
#pragma unroll
            for (int t = 0; t < 2; ++t) { const int row = pb + 8 * t + wave; f32x4 v[4];
#pragma unroll
                for (int j = 0; j < 4; ++j) v[j] = vn[t][j];
                if (pb + 16 < hi) { const int r = row + 16; load_x1(phys(r < hi ? r : lo), ctxp, vn[t]); }
                if (ctxp && row < hi) store_row_bf16(xb_row(F, phys(row)), lane, v);
                const float rstd = rsqrtf(row_sumsq(v) * (1.f / D) + EPS);
#pragma unroll
                for (int j = 0; j < 4; ++j) { const int c = 4 * lane + 256 * j; v[j] = v[j] * rstd * *(const LAS f32x4*)(lmA + c) + *(const LAS f32x4*)(lmB + c);
                    *(LAS f32x2*)(Ht + (8 * t + wave) * HS_ + c) = (f32x2){v[j].x, v[j].y}; *(LAS f32x2*)(Ht + (8 * t + wave) * HS_ + c + 2) = (f32x2){v[j].z, v[j].w}; }
                if (RMODE != 3) { if (row < hi) { const int pr = phys(row); store_row_i8(F.hq() + (size_t)pr * D, F.hs() + pr, lane, v); } } }
            reduce_prev();
            if (wr_pending) { wr_pending = false;
#pragma unroll
                for (int i = 0; i < 8; ++i) *(LAS f32x4*)(Wr + 4 * (F.tid + NTHREADS * i)) = wreg[i]; }
            __syncthreads();
            if (RMODE != 1) { f32x4 acc = (f32x4){0.f, 0.f, 0.f, 0.f}; const int ar = lane & 15, ag = lane >> 4;
              const LAS float* ap = Ht + ar * HS_ + 128 * wave + 4 * ag; const LAS float* bp = Wr + (128 * wave + 4 * ag) * 16 + ar;
#pragma unroll
              for (int kk = 0; kk < 8; ++kk) { const f32x2 a01 = *(const LAS f32x2*)(ap + 16 * kk), a23 = *(const LAS f32x2*)(ap + 16 * kk + 2);
                  acc = __builtin_amdgcn_mfma_f32_16x16x4f32(a01.x, bp[(16 * kk + 0) * 16], acc, 0, 0, 0);
                  acc = __builtin_amdgcn_mfma_f32_16x16x4f32(a01.y, bp[(16 * kk + 1) * 16], acc, 0, 0, 0);
                  acc = __builtin_amdgcn_mfma_f32_16x16x4f32(a23.x, bp[(16 * kk + 2) * 16], acc, 0, 0, 0);
                  acc = __builtin_amdgcn_mfma_f32_16x16x4f32(a23.y, bp[(16 * kk + 3) * 16], acc, 0, 0, 0); }
              LAS float* pp = Pp;
#pragma unroll
              for (int j = 0; j < 4; ++j) pp[(wave * 16 + 4 * ag + j) * 16 + ar] = acc[j]; }
            __syncthreads();
            prev_pb = pb; prev_hi = hi; ++pi;
        }
        lo = hi;
    }
    reduce_prev();
    __syncthreads();
    if (F.tid < r1 - r0) {
        const int row = r0 + F.tid;
        float s[16], sb[16];
#pragma unroll
        for (int e4 = 0; e4 < 4; ++e4) { const f32x4 q = *(const LAS f32x4*)(Lg + F.tid * 16 + 4 * e4);
            s[4 * e4] = sigmoid_f(q.x); s[4 * e4 + 1] = sigmoid_f(q.y); s[4 * e4 + 2] = sigmoid_f(q.z); s[4 * e4 + 3] = sigmoid_f(q.w); }
#pragma unroll
        for (int e = 0; e < 16; ++e) sb[e] = s[e] + F.in[I_RB][e];
        float gs[4];
#pragma unroll
        for (int g = 0; g < 4; ++g) { const float a = sb[4 * g], b = sb[4 * g + 1], c = sb[4 * g + 2], d = sb[4 * g + 3];
            const float m1 = fmaxf(fmaxf(a, b), fmaxf(c, d));
            const float hi_ab = fmaxf(a, b), lo_ab = fminf(a, b), hi_cd = fmaxf(c, d), lo_cd = fminf(c, d);
            const float m2 = (hi_ab >= hi_cd) ? fmaxf(lo_ab, hi_cd) : fmaxf(lo_cd, hi_ab);
            gs[g] = m1 + m2; }
        int best = 0; float bv = gs[0];
#pragma unroll
        for (int g = 1; g < 4; ++g) if (gs[g] > bv) { bv = gs[g]; best = g; }
        float q[4], qs[4];
#pragma unroll
        for (int j = 0; j < 4; ++j) { q[j] = best == 0 ? sb[j] : best == 1 ? sb[4 + j] : best == 2 ? sb[8 + j] : sb[12 + j]; qs[j] = best == 0 ? s[j] : best == 1 ? s[4 + j] : best == 2 ? s[8 + j] : s[12 + j]; }
        int i1 = 0; float v1 = q[0];
#pragma unroll
        for (int j = 1; j < 4; ++j) if (q[j] > v1) { v1 = q[j]; i1 = j; }
        int i2 = -1; float v2 = -INFINITY;
#pragma unroll
        for (int j = 0; j < 4; ++j) if (j != i1 && q[j] > v2) { v2 = q[j]; i2 = j; }
        const float w1 = i1 == 0 ? qs[0] : i1 == 1 ? qs[1] : i1 == 2 ? qs[2] : qs[3];
        const float w2 = i2 == 0 ? qs[0] : i2 == 1 ? qs[1] : i2 == 2 ? qs[2] : qs[3];
        const float inv = 1.f / (w1 + w2);
        const int e0 = best * 4 + i1, e1 = best * 4 + i2;
        const unsigned lp0 = atomicAdd((unsigned*)(lcnt + e0), 1u), lp1 = atomicAdd((unsigned*)(lcnt + e1), 1u);
        LAS int* rc = rec + F.tid * 6;
        rc[0] = e0; rc[1] = e1; rc[2] = (int)lp0; rc[3] = (int)lp1; rc[4] = __float_as_int(w1 * inv); rc[5] = __float_as_int(w2 * inv);
        (void)row;
    }
    __syncthreads();
    if (F.tid < 16) { const unsigned n = lcnt[F.tid]; lcnt[16 + F.tid] = n ? atomicAdd(cnt + F.tid, n) : 0u; }
    __syncthreads();
    for (int rl = F.tid; rl < r1 - r0; rl += NTHREADS) {
        const LAS int* rc = rec + rl * 6; const int row = phys(r0 + rl), e0 = rc[0], e1 = rc[1];
        const int p0 = (int)lcnt[16 + e0] + rc[2], p1 = (int)lcnt[16 + e1] + rc[3];
        F.list()[(size_t)e0 * NT + p0] = row; F.list()[(size_t)e1 * NT + p1] = row;
        F.toke()[2 * row] = e0; F.toke()[2 * row + 1] = e1; F.tokp()[2 * row] = p0; F.tokp()[2 * row + 1] = p1;
        F.tokw()[2 * row] = __int_as_float(rc[4]); F.tokw()[2 * row + 1] = __int_as_float(rc[5]);
    }
}
__device__ __forceinline__ void phase_norm2_route(Frame& F, int l, int nrows) { phase_norm2_route_t<0>(F, l, nrows); }
struct YRows { u32x2 a[4], b[4]; };
__device__ __forceinline__ void load_y(const Frame& F, const LAS int* ti, int lane, YRows& y) {
    const bf16_t* y0 = F.y() + (size_t)ti[0] * D; const bf16_t* y1 = F.y() + (size_t)ti[1] * D;
#pragma unroll
    for (int j = 0; j < 4; ++j) { y.a[j] = *(const u32x2*)(y0 + 4 * lane + 256 * j); y.b[j] = *(const u32x2*)(y1 + 4 * lane + 256 * j); }
}
template <bool FINAL> __device__ __forceinline__ void phase_combine(Frame& F, int l, int nrows, bool pre = false) {
    const unsigned* cnt = F.ctl() + CW_CNT + 16 * l;
    LAS float* lmA = (LAS float*)F.lds; LAS float* lmB = lmA + 1024; LAS float* lmG = lmB + 1024;
    LAS int* eoff = (LAS int*)(lmG + 1024); LAS int* tinf = eoff + 16;
    const int per = (nrows + F.G - 1) / F.G; const int r0 = blockIdx.x * per; int r1 = r0 + per; if (r1 > nrows) r1 = nrows;
    const bool remap = (nrows == NT) && (F.G == 256); const int bx = (int)blockIdx.x;
    auto phys = [&](int v) { return remap ? ((v - r0) < 64 ? 64 * bx + (v - r0) : NX + 8 * bx + (v - r0 - 64)) : v; };
    if (!pre) {
    __syncthreads();
    if (F.tid == 0) { int o = 0; for (int e = 0; e < 16; ++e) { eoff[e] = o; o += ((int)cnt[e] + 255) & ~255; } }
    __syncthreads();
    for (int rl = F.tid; rl < r1 - r0; rl += NTHREADS) { const int row = phys(r0 + rl);
        tinf[rl * 4] = eoff[F.toke()[2 * row]] + F.tokp()[2 * row]; tinf[rl * 4 + 1] = eoff[F.toke()[2 * row + 1]] + F.tokp()[2 * row + 1];
        tinf[rl * 4 + 2] = __float_as_int(F.tokw()[2 * row]); tinf[rl * 4 + 3] = __float_as_int(F.tokw()[2 * row + 1]); } }
    int lo = r0;
    while (lo < r1) {
        const int grp = phys(lo) / 2048; int hi = remap ? (lo < r0 + 64 ? r0 + 64 : r1) : (grp + 1) * 2048; if (hi > r1) hi = r1;
        const float* mf = F.modf() + (size_t)(l * 9 + grp) * 6144;
        if (!(pre && lo == r0)) {
        __syncthreads();
        for (int n = F.tid; n < 1024; n += NTHREADS) { lmG[n] = mf[5120 + n];
            if (FINAL) { lmA[n] = F.in[I_FG][n]; } else { const float* mn = F.modf() + (size_t)((l + 1) * 9 + grp) * 6144; lmA[n] = F.in[I_N1G][(l + 1) * D + n] * (1.f + mn[1024 + n]); lmB[n] = mn[n]; } }
        __syncthreads(); }
        int row = lo + F.wave; f32x4 vn[4]; YRows yn;
        if (row < hi) { load_row_bf16(xb_row(F, phys(row)), F.lane, vn); load_y(F, tinf + (row - r0) * 4, F.lane, yn); }
        for (; row < hi; row += NWAVES) {
            f32x4 v[4]; YRows y = yn;
#pragma unroll
            for (int j = 0; j < 4; ++j) v[j] = vn[j];
            const float w0 = __int_as_float(tinf[(row - r0) * 4 + 2]), w1 = __int_as_float(tinf[(row - r0) * 4 + 3]);
            if (row + NWAVES < hi) { load_row_bf16(xb_row(F, phys(row + NWAVES)), F.lane, vn); load_y(F, tinf + (row + NWAVES - r0) * 4, F.lane, yn); }
#pragma unroll
            for (int j = 0; j < 4; ++j) { const int c = 4 * F.lane + 256 * j; const f32x4 g2 = *(const LAS f32x4*)(lmG + c); const u32x2 a = y.a[j], b = y.b[j];
                f32x4 m; m.x = w0 * __uint_as_float(a.x << 16) + w1 * __uint_as_float(b.x << 16); m.y = w0 * __uint_as_float(a.x & 0xffff0000u) + w1 * __uint_as_float(b.x & 0xffff0000u);
                m.z = w0 * __uint_as_float(a.y << 16) + w1 * __uint_as_float(b.y << 16); m.w = w0 * __uint_as_float(a.y & 0xffff0000u) + w1 * __uint_as_float(b.y & 0xffff0000u);
                v[j] = v[j] + g2 * m; }
            const float rstd = rsqrtf(row_sumsq(v) * (1.f / D) + EPS);
            if (FINAL) {
#pragma unroll
                for (int j = 0; j < 4; ++j) { const int c = 4 * F.lane + 256 * j; __builtin_nontemporal_store(v[j] * rstd * *(const LAS f32x4*)(lmA + c), (f32x4*)(F.out + (size_t)phys(row) * D + c)); }
            } else {
                store_row_bf16(xb_row(F, phys(row)), F.lane, v);
#pragma unroll
                for (int j = 0; j < 4; ++j) { const int c = 4 * F.lane + 256 * j; v[j] = v[j] * rstd * *(const LAS f32x4*)(lmA + c) + *(const LAS f32x4*)(lmB + c); }
                { const int pr = phys(row); store_row_i8(F.hq() + (size_t)pr * D, F.hs() + pr, F.lane, v); }
            }
        }
        lo = hi;
    }
}

struct CombinePro {
    const Frame* F; int l, nrows; bool fin;
    __device__ __forceinline__ void operator()() const {
        const Frame& f = *F; const unsigned* cnt = f.ctl() + CW_CNT + 16 * l;
        LAS float* lmA = (LAS float*)f.lds; LAS float* lmB = lmA + 1024; LAS float* lmG = lmB + 1024; LAS int* tinf = (LAS int*)(lmG + 1024) + 16;
        const int per = (nrows + f.G - 1) / f.G; const int r0 = (int)blockIdx.x * per; int r1 = r0 + per; if (r1 > nrows) r1 = nrows;
        const bool remap = (nrows == NT) && (f.G == 256); const int bx = (int)blockIdx.x; const int t = (int)threadIdx.x - 64;
        for (int rl = t; rl < r1 - r0; rl += NTHREADS - 64) { const int row = remap ? (rl < 64 ? 64 * bx + rl : NX + 8 * bx + (rl - 64)) : r0 + rl;
            const int e0 = f.toke()[2 * row], e1 = f.toke()[2 * row + 1]; int o0 = 0, o1 = 0;
#pragma unroll
            for (int j = 0; j < 16; ++j) { const int r = ((int)cnt[j] + 255) & ~255; o0 += (j < e0) ? r : 0; o1 += (j < e1) ? r : 0; }
            tinf[rl * 4] = o0 + f.tokp()[2 * row]; tinf[rl * 4 + 1] = o1 + f.tokp()[2 * row + 1];
            tinf[rl * 4 + 2] = __float_as_int(f.tokw()[2 * row]); tinf[rl * 4 + 3] = __float_as_int(f.tokw()[2 * row + 1]); }
        int grp = remap ? (bx >> 5) : r0 / 2048; if (grp > 8) grp = 8;
        const float* mf = f.modf() + (size_t)(l * 9 + grp) * 6144; const float* mn = f.modf() + (size_t)((l + 1) * 9 + grp) * 6144;
        for (int n = t; n < 1024; n += NTHREADS - 64) { lmG[n] = mf[5120 + n];
            if (fin) { lmA[n] = f.in[I_FG][n]; } else { lmA[n] = f.in[I_N1G][(l + 1) * D + n] * (1.f + mn[1024 + n]); lmB[n] = mn[n]; } }
    }
};
template <int NBM, class AR, class BR0, class BR1, class EPI>
__device__ __forceinline__ void ngemm_unit(LAS unsigned char* lds, int tid, AR arow, BR0 brow0, BR1 brow1, int K, EPI epi) {
    const int lane = tid & 63, wave = tid >> 6, wr = wave >> 2, wc = wave & 3, fr = lane & 15, fq = lane >> 4;
    LAS bf16_t* As = (LAS bf16_t*)lds; LAS bf16_t* Bs0 = As + 128 * 40; LAS bf16_t* Bs1 = Bs0 + 128 * 40;
    const int lr = tid >> 2, lc = (tid & 3) * 8;
    const bf16_t* ap = arow(lr) + lc; const bf16_t* bp0 = brow0(lr) + lc; const bf16_t* bp1 = brow1(lr) + lc;
    f32x4 acc0[4][2], acc1[4][2];
#pragma unroll
    for (int m = 0; m < 4; ++m)
#pragma unroll
        for (int n = 0; n < 2; ++n) { acc0[m][n] = (f32x4){0.f, 0.f, 0.f, 0.f}; acc1[m][n] = (f32x4){0.f, 0.f, 0.f, 0.f}; }
    for (int k0 = 0; k0 < K; k0 += 32) {
        const u32x4 va = *(const u32x4*)(ap + k0), vb0 = *(const u32x4*)(bp0 + k0); u32x4 vb1 = va; if (NBM > 1) vb1 = *(const u32x4*)(bp1 + k0);
        __syncthreads();
        *(LAS u32x4*)(As + lr * 40 + lc) = va; *(LAS u32x4*)(Bs0 + lr * 40 + lc) = vb0; if (NBM > 1) *(LAS u32x4*)(Bs1 + lr * 40 + lc) = vb1;
        __syncthreads();
        bf16x8 a[4], b0[2], b1[2];
#pragma unroll
        for (int m = 0; m < 4; ++m) a[m] = *(const LAS bf16x8*)(As + (wr * 64 + m * 16 + fr) * 40 + fq * 8);
#pragma unroll
        for (int n = 0; n < 2; ++n) { b0[n] = *(const LAS bf16x8*)(Bs0 + (wc * 32 + n * 16 + fr) * 40 + fq * 8); if (NBM > 1) b1[n] = *(const LAS bf16x8*)(Bs1 + (wc * 32 + n * 16 + fr) * 40 + fq * 8); else b1[n] = b0[n]; }
#pragma unroll
        for (int m = 0; m < 4; ++m)
#pragma unroll
            for (int n = 0; n < 2; ++n) { acc0[m][n] = __builtin_amdgcn_mfma_f32_16x16x32_bf16(a[m], b0[n], acc0[m][n], 0, 0, 0);
                if (NBM > 1) acc1[m][n] = __builtin_amdgcn_mfma_f32_16x16x32_bf16(a[m], b1[n], acc1[m][n], 0, 0, 0); }
    }
#pragma unroll
    for (int m = 0; m < 4; ++m)
#pragma unroll
        for (int n = 0; n < 2; ++n)
#pragma unroll
            for (int j = 0; j < 4; ++j) epi(wr * 64 + m * 16 + fq * 4 + j, wc * 32 + n * 16 + fr, acc0[m][n][j], acc1[m][n][j]);
    __syncthreads();
}

__device__ __forceinline__ void phase_gemm1_naive(Frame& F) {
    for (int u = blockIdx.x; u < 144 * 32; u += F.G) {
        const int mt = u / 32, nt = u % 32;
        const bf16_t* A = F.h() + (size_t)mt * 128 * D; const bf16_t* B = F.win() + (size_t)nt * 128 * D;
        bf16_t* U = F.u(); bf16_t* VT = F.vt();
        ngemm_unit<1>(F.lds, F.tid, [=](int r) { return A + (size_t)r * D; }, [=](int n) { return B + (size_t)n * D; }, [=](int n) { return B + (size_t)n * D; }, D,
            [=](int r, int c, float v, float) { const int row = mt * 128 + r, col = nt * 128 + c; const float g = gelu_tanh(v);
                if (col < AW) U[(size_t)row * AW + col] = (bf16_t)f2bf(g); else VT[(size_t)(col - AW) * NT + row] = (bf16_t)f2bf(g); });
    }
}
__device__ __forceinline__ void phase_vsq_naive(Frame& F) {
    for (int tok = blockIdx.x * NTHREADS + F.tid; tok < NT; tok += F.G * NTHREADS) {
        float s = 0.f;
        for (int ch = 0; ch < AW; ++ch) { const float v = bf2f(F.vt()[(size_t)ch * NT + tok]); s += v * v; }
        F.vsq()[(size_t)tok * 32] = s;
        for (int j = 1; j < 32; ++j) F.vsq()[(size_t)tok * 32 + j] = 0.f;
    }
}
__device__ __forceinline__ void phase_vnorm_naive(Frame& F) {
    for (int tok = blockIdx.x * NTHREADS + F.tid; tok < NT; tok += F.G * NTHREADS) {
        float s = 0.f;
        for (int j = 0; j < 32; ++j) s += F.vsq()[(size_t)tok * 32 + j];
        const float rstd = rsqrtf(s * (1.f / AW) + EPS);
        for (int ch = 0; ch < AW; ++ch) { const size_t i = (size_t)ch * NT + tok; F.vt()[i] = (bf16_t)f2bf(bf2f(F.vt()[i]) * rstd * F.in[I_AGV][ch]); }
    }
}
__device__ __forceinline__ void phase_sgu_naive(Frame& F) {
    for (int u = blockIdx.x; u < 144 * 16; u += F.G) {
        const int c = u / 16, g = (u % 16) >> 1, nh = u & 1;
        const bf16_t* A = F.wsbf() + (size_t)g * 128 * 128; const bf16_t* B = F.vt() + (size_t)(g * 256 + nh * 128) * NT + (size_t)c * 128;
        bf16_t* U = F.u(); const float* bs = F.in[I_ABS] + g * 128;
        ngemm_unit<1>(F.lds, F.tid, [=](int r) { return A + (size_t)r * 128; }, [=](int n) { return B + (size_t)n * NT; }, [=](int n) { return B + (size_t)n * NT; }, 128,
            [=](int r, int ci, float v, float) { const size_t i = (size_t)(c * 128 + r) * AW + g * 256 + nh * 128 + ci; U[i] = (bf16_t)f2bf(bf2f(U[i]) * (v + bs[r])); });
    }
}
__device__ __forceinline__ void phase_gemm2_naive(Frame& F) {
    for (int u = blockIdx.x; u < 144 * 8; u += F.G) {
        const int mt = u / 8, nt = u % 8;
        const bf16_t* A = F.u() + (size_t)mt * 128 * U_LD; const bf16_t* B = F.wout() + (size_t)nt * 128 * AW;
        bf16_t* xbh = F.xbh(); const float* x0 = F.in[I_X]; const float* c0 = F.in[I_CTX]; const float* mf = F.modf();
        ngemm_unit<1>(F.lds, F.tid, [=](int r) { return A + (size_t)r * U_LD; }, [=](int n) { return B + (size_t)n * AW; }, [=](int n) { return B + (size_t)n * AW; }, AW,
            [=](int r, int c, float v, float) { const int row = mt * 128 + r, col = nt * 128 + c; const float g1 = mf[(size_t)(row / 2048) * 6144 + 2048 + col];
                const float xin = row < NX ? x0[(size_t)row * D + col] : c0[(size_t)(row - NX) * D + col]; xbh[(size_t)row * D + col] = (bf16_t)f2bf(xin + g1 * v); });
    }
}
__device__ __forceinline__ void phase_gateup_naive(Frame& F, int l) {
    const unsigned* cnt = F.ctl() + CW_CNT + 16 * l;
    int ubase = 0, off = 0;
    for (int e = 0; e < NE; ++e) {
        const int n = (int)cnt[e], mt128 = ((n + 255) >> 8) * 2, nu = mt128 * 4;
        int u = blockIdx.x; if (u < ubase) u += ((ubase - u + F.G - 1) / F.G) * F.G;
        for (; u < ubase + nu; u += F.G) {
            const int lu = u - ubase, mt = lu >> 2, pn = lu & 3;
            const int* lst = F.list() + (size_t)e * NT; const bf16_t* H = F.h(); const bf16_t* B = F.gu() + (size_t)(l * 16 + e) * 1024 * 1024 + (size_t)pn * 256 * 1024;
            bf16_t* HID = F.hid() + (size_t)(off + mt * 128) * DE + pn * 128;
            ngemm_unit<2>(F.lds, F.tid, [=](int r) { const int sr = mt * 128 + r; const int tok = lst[sr < n ? sr : 0]; return H + (size_t)tok * D; },
                [=](int c) { return B + (size_t)c * 1024; }, [=](int c) { return B + (size_t)(128 + c) * 1024; }, D,
                [=](int r, int c, float g, float up) { HID[(size_t)r * DE + c] = (bf16_t)f2bf(silu_f(g) * up); });
        }
        ubase += nu; off += (n + 255) & ~255;
    }
}
__device__ __forceinline__ void phase_down_naive(Frame& F, int l) {
    const unsigned* cnt = F.ctl() + CW_CNT + 16 * l;
    int ubase = 0, off = 0;
    for (int e = 0; e < NE; ++e) {
        const int n = (int)cnt[e], mt128 = ((n + 255) >> 8) * 2, nu = mt128 * 8;
        int u = blockIdx.x; if (u < ubase) u += ((ubase - u + F.G - 1) / F.G) * F.G;
        for (; u < ubase + nu; u += F.G) {
            const int lu = u - ubase, mt = lu >> 3, nt = lu & 7;
            const bf16_t* A = F.hid() + (size_t)(off + mt * 128) * DE; const bf16_t* B = F.dn() + (size_t)(l * 16 + e) * 1024 * 512 + (size_t)nt * 128 * 512;
            bf16_t* Y = F.y() + (size_t)(off + mt * 128) * D + nt * 128;
            ngemm_unit<1>(F.lds, F.tid, [=](int r) { return A + (size_t)r * DE; }, [=](int c) { return B + (size_t)c * DE; }, [=](int c) { return B + (size_t)c * DE; }, DE,
                [=](int r, int c, float v, float) { Y[(size_t)r * D + c] = (bf16_t)f2bf(v); });
        }
        ubase += nu; off += (n + 255) & ~255;
    }
}
__device__ __forceinline__ void phase_qkv_naive(Frame& F) {
    for (int u = blockIdx.x; u < 144 * 12; u += F.G) {
        const int mt = u / 12, nt = u % 12;
        if (mt >= 128 && nt < 8) continue;
        const bf16_t* A = F.h() + (size_t)mt * 128 * D; const bf16_t* B = F.wqkv() + (size_t)nt * 128 * D;
        bf16_t *Q = F.q(), *K = F.k(), *V = F.v();
        ngemm_unit<1>(F.lds, F.tid, [=](int r) { return A + (size_t)r * D; }, [=](int n) { return B + (size_t)n * D; }, [=](int n) { return B + (size_t)n * D; }, D,
            [=](int r, int c, float v, float) { const int row = mt * 128 + r, col = nt * 128 + c;
                if (col < 1024) Q[(size_t)row * 1024 + col] = (bf16_t)f2bf(v); else if (col < 1280) K[(size_t)row * KVD + col - 1024] = (bf16_t)f2bf(v); else V[(size_t)row * KVD + col - 1280] = (bf16_t)f2bf(v); });
    }
}
__device__ __forceinline__ void phase_rope_naive(Frame& F) {
    for (int idx = blockIdx.x * NTHREADS + F.tid; idx < NX * 640; idx += F.G * NTHREADS) {
        const int f = idx & 15, a = (idx >> 4) & 1, hs = (idx >> 5) % 20, row = idx / 640;
        bf16_t* p = hs < 16 ? F.q() + (size_t)row * 1024 + hs * 64 : F.k() + (size_t)row * KVD + (hs - 16) * 64;
        const float x1 = bf2f(p[a * 32 + f]), x2 = bf2f(p[a * 32 + 16 + f]);
        const int pos = row & 2047; const float pp = (float)(a ? (pos & 63) : (pos >> 6));
        const float inv = exp2f(-(float)f * (13.287712379549449f / 16.f));
        float rev = pp * inv * 0.15915494309189535f; rev -= floorf(rev);
        const float sn = __builtin_amdgcn_sinf(rev), cs = __builtin_amdgcn_cosf(rev);
        const float sc = hs < 16 ? QSCALE : 1.f;
        p[a * 32 + f] = (bf16_t)f2bf((x1 * cs - x2 * sn) * sc); p[a * 32 + 16 + f] = (bf16_t)f2bf((x2 * cs + x1 * sn) * sc);
    }
}
__device__ __forceinline__ void phase_attn_naive(Frame& F) {
    for (int idx = blockIdx.x * NTHREADS + F.tid; idx < NX * 16; idx += F.G * NTHREADS) {
        const int pos = idx & 2047, head = (idx >> 11) & 15, b = idx >> 15, hk = head >> 2;
        const int row = b * SEQ + pos;
        float q[64], o[64];
        { const bf16_t* qp = F.q() + (size_t)row * 1024 + head * 64;
#pragma unroll
          for (int d8 = 0; d8 < 8; ++d8) { const u32x4 w = *(const u32x4*)(qp + 8 * d8);
#pragma unroll
              for (int i = 0; i < 4; ++i) { q[8 * d8 + 2 * i] = __uint_as_float(w[i] << 16); q[8 * d8 + 2 * i + 1] = __uint_as_float(w[i] & 0xffff0000u); } } }
#pragma unroll
        for (int d = 0; d < 64; ++d) o[d] = 0.f;
        float m = F.in[I_BSINK][head] * LOG2E, lsum = 1.f;
        const int w_lo = pos - 128 < 0 ? 0 : pos - 128, w_hi = pos + 128 > SEQ - 1 ? SEQ - 1 : pos + 128;
        const int nwin = w_hi - w_lo + 1;
        for (int j = 0; j < CTXL + nwin; ++j) {
            const int krow = j < CTXL ? NX + b * CTXL + j : b * SEQ + w_lo + (j - CTXL);
            const bf16_t* kp = F.k() + (size_t)krow * KVD + hk * 64; const bf16_t* vp = F.v() + (size_t)krow * KVD + hk * 64;
            float s = 0.f;
#pragma unroll
            for (int d8 = 0; d8 < 8; ++d8) { const u32x4 w = *(const u32x4*)(kp + 8 * d8);
#pragma unroll
                for (int i = 0; i < 4; ++i) { s += q[8 * d8 + 2 * i] * __uint_as_float(w[i] << 16); s += q[8 * d8 + 2 * i + 1] * __uint_as_float(w[i] & 0xffff0000u); } }
            const float mn = fmaxf(m, s), f = exp2f(m - mn), pj = exp2f(s - mn);
            lsum = lsum * f + pj; m = mn;
#pragma unroll
            for (int d8 = 0; d8 < 8; ++d8) { const u32x4 w = *(const u32x4*)(vp + 8 * d8);
#pragma unroll
                for (int i = 0; i < 4; ++i) { o[8 * d8 + 2 * i] = o[8 * d8 + 2 * i] * f + pj * __uint_as_float(w[i] << 16); o[8 * d8 + 2 * i + 1] = o[8 * d8 + 2 * i + 1] * f + pj * __uint_as_float(w[i] & 0xffff0000u); } }
        }
        const float il = 1.f / lsum;
        bf16_t* op = F.o() + (size_t)row * 1024 + head * 64;
#pragma unroll
        for (int d8 = 0; d8 < 8; ++d8) { u32x4 w;
#pragma unroll
            for (int i = 0; i < 4; ++i) w[i] = pk2(o[8 * d8 + 2 * i] * il, o[8 * d8 + 2 * i + 1] * il);
            *(u32x4*)(op + 8 * d8) = w; }
    }
}
__device__ __forceinline__ void phase_wo_naive(Frame& F) {
    for (int u = blockIdx.x; u < 128 * 8; u += F.G) {
        const int mt = u / 8, nt = u % 8;
        const bf16_t* A = F.o() + (size_t)mt * 128 * D; const bf16_t* B = F.wo() + (size_t)nt * 128 * D;
        bf16_t* out = F.xbh(); const float* mf = F.modf() + (size_t)9 * 6144;
        ngemm_unit<1>(F.lds, F.tid, [=](int r) { return A + (size_t)r * D; }, [=](int n) { return B + (size_t)n * D; }, [=](int n) { return B + (size_t)n * D; }, D,
            [=](int r, int c, float v, float) { const int row = mt * 128 + r, col = nt * 128 + c; const float g1 = mf[(size_t)(row / 2048) * 6144 + 2048 + col];
                out[(size_t)row * D + col] = (bf16_t)f2bf(bf2f(out[(size_t)row * D + col]) + g1 * v); });
    }
}

namespace pg8 {
constexpr int BM = 256, BK = 64, HALF = 128, HTB = HALF * BK * 2, STAGE_BYTES = 8 * HTB;
__device__ __forceinline__ int lds_byte(int r, int c) { const int st = (r >> 4) * 2 + (c >> 5), rr = r & 15, cc = c & 31, ob = rr * 64 + cc * 2; return st * 1024 + (ob ^ (((ob >> 9) & 1) << 5)); }
__device__ __forceinline__ void stage_rc(int b, int& R, int& C) { const int st = b / 1024, sb = b % 1024, swz = sb ^ (((sb >> 9) & 1) << 5); R = (st >> 1) * 16 + swz / 64; C = (st & 1) * 32 + (swz % 64) / 2; }
__device__ __forceinline__ int perm32(int rho) { const int n = rho >> 4, i = rho & 15; return 8 * (i >> 2) + 4 * n + (i & 3); }

struct Unit { int pm, pn, e, aux, lbase, sel, koff; };
struct Gemm { const void* A; const void* Bt; int lda, ldb, K; size_t bstride; };
typedef int v4i32 __attribute__((ext_vector_type(4)));

template <class Epi, class Sched, bool GATHER, bool SWAPMODE, bool ALIGN_EPI, bool I8 = false>
__device__ __forceinline__ void gemm_phase(LAS unsigned char* lds, const Gemm g, const Sched& S, const Epi& E, LAS int* idxtab) {
    const int tid = threadIdx.x, wid = __builtin_amdgcn_readfirstlane(tid >> 6), lane = tid & 63, wr = wid >> 2, wc = wid & 3, fr = lane & 15, fq = lane >> 4;
    const int nt = g.K / (BK * 2);
    unsigned voffA[2], voffB[2]; int RA[2], CA2[2];
#pragma unroll
    for (int i = 0; i < 2; ++i) { int R, C; stage_rc(tid * 16 + i * 8192, R, C); const int Rb = Epi::PERM ? ((R & ~31) + perm32(R & 31)) : R;
        voffA[i] = (unsigned)(R * g.lda + C * 2); voffB[i] = (unsigned)(Rb * g.ldb + C * 2); RA[i] = R; CA2[i] = C * 2; }
    const size_t kstep = (size_t)(BK * 2);
    const size_t hstepA = (size_t)HALF * g.lda, hstepB = (size_t)HALF * g.ldb, tstepA = 2 * hstepA, tstepB = 2 * hstepB;
    const unsigned ldsw = (unsigned)wid * 1024u;
    const int aoff = lds_byte(wr * 64 + fr, fq * 8), boff = lds_byte(wc * 32 + fr, fq * 8);
#define PG8_SA(b, h) (((b) * 2 + (h)) * HTB)
#define PG8_SB(b, h) ((4 + (b) * 2 + (h)) * HTB)
#define PG8_STG(bufoff, P0, P1) do { \
        __builtin_amdgcn_global_load_lds((const unsigned*)(P0), (LAS unsigned*)(lds + (bufoff) + ldsw), 16, 0, 0); \
        __builtin_amdgcn_global_load_lds((const unsigned*)(P1), (LAS unsigned*)(lds + (bufoff) + ldsw + 8192), 16, 0, 0); } while (0)
#define PG8_STGA(bufoff, P0, P1) do { \
        __builtin_amdgcn_global_load_lds((const unsigned*)(P0), (LAS unsigned*)(lds + (bufoff) + ldsw), 16, 0, Sched::WAITS ? 16 : 0); \
        __builtin_amdgcn_global_load_lds((const unsigned*)(P1), (LAS unsigned*)(lds + (bufoff) + ldsw + 8192), 16, 0, Sched::WAITS ? 16 : 0); } while (0)
#define PG8_STAGE_B(bufoff, base) PG8_STG(bufoff, (base) + voffB[0], (base) + voffB[1])
#define PG8_STAGE_A(bufoff, base, h, GS) do { if constexpr (GATHER) { PG8_STGA(bufoff, (base) + GS[h][0], (base) + GS[h][1]); } \
        else { PG8_STGA(bufoff, (base) + (h) * hstepA + voffA[0], (base) + (h) * hstepA + voffA[1]); } } while (0)
#define PG8_LDA(dst, b, h) do { _Pragma("unroll") for (int m = 0; m < 4; ++m) _Pragma("unroll") for (int k = 0; k < 2; ++k) dst[m][k] = *(const LAS bf16x8*)(lds + PG8_SA(b, h) + aoff + m * 2048 + k * 1024); } while (0)
#define PG8_LDB(dst, b, h) do { _Pragma("unroll") for (int n = 0; n < 2; ++n) _Pragma("unroll") for (int k = 0; k < 2; ++k) dst[n][k] = *(const LAS bf16x8*)(lds + PG8_SB(b, h) + boff + n * 2048 + k * 1024); } while (0)
#define PG8_MMA(ai, bj, At, Bt_) do { __builtin_amdgcn_s_setprio(1); \
        if (SWAPMODE && swapc) { _Pragma("unroll") for (int m = 0; m < 4; ++m) _Pragma("unroll") for (int n = 0; n < 2; ++n) _Pragma("unroll") for (int k = 0; k < 2; ++k) \
            acc[ai][bj][m][n] = __builtin_amdgcn_mfma_f32_16x16x32_bf16(At[m][k], Bt_[n][k], acc[ai][bj][m][n], 0, 0, 0); } \
        else if constexpr (I8) { _Pragma("unroll") for (int m = 0; m < 4; ++m) _Pragma("unroll") for (int n = 0; n < 2; ++n) _Pragma("unroll") for (int k = 0; k < 2; ++k) \
            acc[ai][bj][m][n] = __builtin_bit_cast(f32x4, __builtin_amdgcn_mfma_i32_16x16x64_i8(__builtin_bit_cast(v4i32, Bt_[n][k]), __builtin_bit_cast(v4i32, At[m][k]), __builtin_bit_cast(v4i32, acc[ai][bj][m][n]), 0, 0, 0)); } \
        else { _Pragma("unroll") for (int m = 0; m < 4; ++m) _Pragma("unroll") for (int n = 0; n < 2; ++n) _Pragma("unroll") for (int k = 0; k < 2; ++k) \
            acc[ai][bj][m][n] = __builtin_amdgcn_mfma_f32_16x16x32_bf16(Bt_[n][k], At[m][k], acc[ai][bj][m][n], 0, 0, 0); } \
        __builtin_amdgcn_s_setprio(0); } while (0)
#define PG8_WAIT_V(n) asm volatile("s_waitcnt vmcnt(" #n ")" ::: "memory")
#define PG8_WAIT_L(n) asm volatile("s_waitcnt lgkmcnt(" #n ")" ::: "memory")
#define PG8_BAR __builtin_amdgcn_s_barrier()
#define PG8_SCHED __builtin_amdgcn_sched_barrier(0)
    Unit cur, nxt; int ui = 0;
    if (!S.next(0, cur)) return;
    int sig_pm = 0; bool sig_pending = false; unsigned peek = 0u;
    if constexpr (Sched::WAITS) S.a_ready(cur, wid, 0u);
    f32x4 acc[2][2][4][2];
#pragma unroll
    for (int a = 0; a < 2; ++a)
#pragma unroll
        for (int b = 0; b < 2; ++b)
#pragma unroll
            for (int m = 0; m < 4; ++m)
#pragma unroll
                for (int n = 0; n < 2; ++n) acc[a][b][m][n] = (f32x4){0.f, 0.f, 0.f, 0.f};
    bf16x8 At[4][2], B0[2][2], B1[2][2];
    const char* gA = (const char*)g.A; const char* gB = (const char*)g.Bt;
    const char* cA = GATHER ? gA : gA + (size_t)cur.pm * tstepA + cur.koff;
    const char* cB = gB + (size_t)cur.e * g.bstride + (size_t)cur.pn * tstepB + cur.koff;
    bool swapc = SWAPMODE ? (cur.aux != 0) : false;
    unsigned gc[2][2], gn[2][2], g2[2][2];
    if constexpr (GATHER) {
#pragma unroll
        for (int h = 0; h < 2; ++h)
#pragma unroll
            for (int i = 0; i < 2; ++i) { gc[h][i] = (unsigned)(*S.idx_ptr(cur, h * HALF + RA[i])) * (unsigned)g.lda + (unsigned)CA2[i]; gn[h][i] = gc[h][i]; g2[h][i] = gc[h][i]; }
        if (wid < 4) idxtab[wid * 64 + lane] = *S.idx_ptr(cur, wid * 64 + lane);
    } else {
#pragma unroll
        for (int h = 0; h < 2; ++h)
#pragma unroll
            for (int i = 0; i < 2; ++i) { gc[h][i] = 0u; gn[h][i] = 0u; g2[h][i] = 0u; }
    }
    PG8_STAGE_B(PG8_SB(0, 0), cB); PG8_STAGE_B(PG8_SB(0, 1), cB + hstepB); PG8_STAGE_A(PG8_SA(0, 0), cA, 0, gc); PG8_STAGE_A(PG8_SA(0, 1), cA, 1, gc);
    if (wr == 1) PG8_BAR;
    PG8_WAIT_V(2); PG8_BAR;
    PG8_STAGE_B(PG8_SB(1, 0), cB + kstep); PG8_STAGE_A(PG8_SA(1, 0), cA + kstep, 0, gc); PG8_STAGE_B(PG8_SB(1, 1), cB + hstepB + kstep);
    PG8_WAIT_V(6); PG8_BAR;
    for (;;) {
        const bool has_next = S.next(ui + 1, nxt);
        const char* nA = GATHER ? gA : (has_next ? gA + (size_t)nxt.pm * tstepA + nxt.koff : cA);
        const char* nB = has_next ? gB + (size_t)nxt.e * g.bstride + (size_t)nxt.pn * tstepB + nxt.koff : cB;
        if constexpr (GATHER) { if (has_next && wid < 4) __builtin_amdgcn_global_load_lds((const unsigned*)S.idx_ptr(nxt, wid * 64 + lane), (LAS unsigned*)(idxtab + ((ui + 1) % 3) * 256 + wid * 64), 4, 0, 0); }
        for (int t = 0; t < nt; t += 2) {
            const bool last = (t == nt - 2);
            if constexpr (Sched::SIGNALS) { if (t == 2 && sig_pending) { S.signal(sig_pm, lane); sig_pending = false; } }
            if constexpr (Sched::WAITS) { if (t == 0 && has_next && wid == 0) peek = S.peek(nxt); if (last && has_next) S.a_ready(nxt, wid, peek); }
            const char* a1 = cA + (size_t)(t + 1) * kstep;
            const char* a2 = last ? nA : cA + (size_t)(t + 2) * kstep; const char* b2 = last ? nB : cB + (size_t)(t + 2) * kstep;
            const char* a3 = a2 + kstep; const char* b3 = b2 + kstep;
            if constexpr (GATHER) {
                if (last) {
                    if (has_next) {
#pragma unroll
                        for (int h = 0; h < 2; ++h)
#pragma unroll
                            for (int i = 0; i < 2; ++i) gn[h][i] = (unsigned)idxtab[((ui + 1) % 3) * 256 + h * HALF + RA[i]] * (unsigned)g.lda + (unsigned)CA2[i];
                    }
#pragma unroll
                    for (int h = 0; h < 2; ++h)
#pragma unroll
                        for (int i = 0; i < 2; ++i) g2[h][i] = gn[h][i];
                }
            }
            PG8_LDB(B0, 0, 0); PG8_LDB(B1, 0, 1); PG8_SCHED; PG8_LDA(At, 0, 0); PG8_STAGE_A(PG8_SA(1, 1), a1, 1, gc);
            PG8_WAIT_V(8); PG8_WAIT_L(0); PG8_BAR; PG8_MMA(0, 0, At, B0); PG8_MMA(0, 1, At, B1); PG8_BAR; PG8_SCHED;
            PG8_LDA(At, 0, 1); PG8_STAGE_B(PG8_SB(0, 0), b2); PG8_STAGE_B(PG8_SB(0, 1), b2 + hstepB); PG8_STAGE_A(PG8_SA(0, 0), a2, 0, g2);
            PG8_WAIT_V(8); PG8_WAIT_L(0); PG8_BAR; PG8_MMA(1, 0, At, B0); PG8_MMA(1, 1, At, B1); PG8_BAR; PG8_SCHED;
            PG8_LDB(B0, 1, 0); PG8_LDB(B1, 1, 1); PG8_SCHED; PG8_LDA(At, 1, 0); PG8_STAGE_A(PG8_SA(0, 1), a2, 1, g2);
            PG8_WAIT_V(8); PG8_WAIT_L(0); PG8_BAR; PG8_MMA(0, 0, At, B0); PG8_MMA(0, 1, At, B1); PG8_BAR; PG8_SCHED;
            PG8_LDA(At, 1, 1); PG8_STAGE_B(PG8_SB(1, 0), b3); PG8_STAGE_B(PG8_SB(1, 1), b3 + hstepB); PG8_STAGE_A(PG8_SA(1, 0), a3, 0, g2);
            PG8_WAIT_V(8); PG8_WAIT_L(0); PG8_BAR; PG8_MMA(1, 0, At, B0); PG8_MMA(1, 1, At, B1); PG8_BAR; PG8_SCHED;
        }
        if constexpr (ALIGN_EPI) { if (wr == 0) PG8_BAR; }
        cur.sel = ui % 3;
        E(acc, cur, wr, wc, fr, fq);
        if constexpr (Sched::SIGNALS) { sig_pm = cur.pm; sig_pending = true; }
        if (!has_next) break;
#pragma unroll
        for (int a = 0; a < 2; ++a)
#pragma unroll
            for (int b = 0; b < 2; ++b)
#pragma unroll
                for (int m = 0; m < 4; ++m)
#pragma unroll
                    for (int n = 0; n < 2; ++n) acc[a][b][m][n] = (f32x4){0.f, 0.f, 0.f, 0.f};
        cur = nxt; cA = nA; cB = nB; ++ui;
        if constexpr (SWAPMODE) swapc = (cur.aux != 0);
        if constexpr (GATHER) {
#pragma unroll
            for (int h = 0; h < 2; ++h)
#pragma unroll
                for (int i = 0; i < 2; ++i) { gc[h][i] = gn[h][i]; g2[h][i] = gn[h][i]; }
        }
        if constexpr (ALIGN_EPI) { if (wr == 1) PG8_BAR; }
    }
    PG8_WAIT_V(0);
    if constexpr (Sched::SIGNALS) { if (sig_pending) S.signal(sig_pm, lane); }
    if constexpr (!ALIGN_EPI) { if (wr == 0) PG8_BAR; }
    PG8_BAR;
#undef PG8_SA
#undef PG8_SB
#undef PG8_STG
#undef PG8_STGA
#undef PG8_STAGE_A
#undef PG8_STAGE_B
#undef PG8_LDA
#undef PG8_LDB
#undef PG8_MMA
#undef PG8_WAIT_V
#undef PG8_WAIT_L
#undef PG8_BAR
#undef PG8_SCHED
}

constexpr int NXCD = 8, WGM = 8;
struct StaticOrder {      static constexpr bool WAITS = false, SIGNALS = false;
    int nM, nN, nwg, G, c, swap_from;
    __device__ void init(int M, int N, int G_, int c_, int swap_from_ = 1 << 30) { nM = M / BM; nN = N / BM; nwg = nM * nN; G = G_; c = c_; swap_from = swap_from_; }
    __device__ bool next(int i, Unit& u) const {
        const long L = (long)i * G + c; if (L >= nwg) return false;
        int wgid = (int)L; { const int q = nwg / NXCD, r = nwg % NXCD, xcd = wgid % NXCD, off = wgid / NXCD; wgid = (xcd < r ? xcd * (q + 1) : r * (q + 1) + (xcd - r) * q) + off; }
        const int nig = WGM * nN, gid = wgid / nig, fm = gid * WGM, gsz = (nM - fm) < WGM ? (nM - fm) : WGM;
        u.pm = fm + ((wgid % nig) % gsz); u.pn = (wgid % nig) / gsz; u.e = 0; u.aux = (u.pn >= swap_from) ? 1 : 0; u.lbase = 0; u.koff = 0; return true;
    }
    __device__ const int* idx_ptr(const Unit&, int) const { return nullptr; }
};
struct StaticOrderW : StaticOrder {
    static constexpr bool WAITS = true, SIGNALS = false;
    unsigned* rdy; unsigned* tmo; unsigned need;
    __device__ __forceinline__ unsigned peek(const Unit& u) const { return __hip_atomic_load(rdy + 64 * u.pm, __ATOMIC_RELAXED, __HIP_MEMORY_SCOPE_AGENT); }
    __device__ __forceinline__ void a_ready(const Unit& u, int wid, unsigned peeked) const {
        if (wid == 0 && (unsigned)__builtin_amdgcn_readfirstlane(peeked) < need) {
            unsigned sp = 0u;
            while ((unsigned)__builtin_amdgcn_readfirstlane(__hip_atomic_load(rdy + 64 * u.pm, __ATOMIC_RELAXED, __HIP_MEMORY_SCOPE_AGENT)) < need) {
                __builtin_amdgcn_s_sleep(2);
                if ((++sp & 255u) == 0u) { if (__hip_atomic_load(tmo, __ATOMIC_RELAXED, __HIP_MEMORY_SCOPE_AGENT)) break; if (sp > XB_SPIN_CAP) { atomicAdd(tmo, 1u); break; } } }
        }
        asm volatile("" ::: "memory"); __builtin_amdgcn_s_barrier(); asm volatile("" ::: "memory");
    }
};
struct QkvOrder {         static constexpr bool WAITS = false, SIGNALS = false;
    int G, c;
    __device__ bool next(int i, Unit& u) const {
        const int L = i * G + c; if (L >= 400) return false;
        if (L < 384) { u.pm = (L / 48) * 8 + (L % 8); u.pn = (L % 48) / 8; } else { const int r = L - 384; u.pm = 64 + (r % 8); u.pn = 4 + r / 8; }
        u.e = 0; u.aux = 0; u.lbase = 0; u.koff = 0; return true;
    }
    __device__ const int* idx_ptr(const Unit&, int) const { return nullptr; }
};
template <int MODE> struct MoeOrderT {
    static constexpr bool WAITS = (MODE == 2), SIGNALS = (MODE == 1);
    const LAS int* tab; const int* list; int G, c; unsigned* rdy; unsigned* tmo;
    __device__ bool next(int i, Unit& u) const {
        const int L0 = i * G + c; const int total = tab[16] * 4; if (L0 >= total) return false;
        int L = L0;
        if (G == 256 && (i + 1) * 256 <= total) { const int x = c & 7, j = c >> 3; L = i * 256 + (((x >> 1) * 16 + (j >> 1)) << 2) + (((x & 1) << 1) | (j & 1)); }
        const int T = L >> 2; int e = 0;
#pragma unroll
        for (int j = 1; j < 16; ++j) e += (T >= tab[j]) ? 1 : 0;
        const int mt = T - tab[e]; int valid = tab[17 + e] - mt * 256; if (valid > 256) valid = 256;
        u.pm = T; u.pn = L & 3; u.e = e; u.aux = valid; u.lbase = e * NT + mt * 256; u.koff = 0; return true;
    }
    __device__ const int* idx_ptr(const Unit& u, int r) const { return list + u.lbase + (r < u.aux ? r : 0); }
    __device__ __forceinline__ void signal(int pm, int lane) const { if (lane == 0) (void)__hip_atomic_fetch_add(rdy + 64 * pm, 1u, __ATOMIC_RELAXED, __HIP_MEMORY_SCOPE_AGENT); }
    __device__ __forceinline__ unsigned peek(const Unit& u) const { return __hip_atomic_load(rdy + 64 * u.pm, __ATOMIC_RELAXED, __HIP_MEMORY_SCOPE_AGENT); }
    __device__ __forceinline__ void a_ready(const Unit& u, int wid, unsigned peeked) const {
        if (wid == 0 && (unsigned)__builtin_amdgcn_readfirstlane(peeked) < 32u) {
            unsigned sp = 0u;
            while ((unsigned)__builtin_amdgcn_readfirstlane(__hip_atomic_load(rdy + 64 * u.pm, __ATOMIC_RELAXED, __HIP_MEMORY_SCOPE_AGENT)) < 32u) {
                __builtin_amdgcn_s_sleep(2);
                if ((++sp & 255u) == 0u) { if (__hip_atomic_load(tmo, __ATOMIC_RELAXED, __HIP_MEMORY_SCOPE_AGENT)) break; if (sp > XB_SPIN_CAP) { atomicAdd(tmo, 1u); break; } } }
        }
        asm volatile("" ::: "memory"); __builtin_amdgcn_s_barrier(); asm volatile("" ::: "memory");
    }
};
typedef MoeOrderT<0> MoeOrder;
}

__device__ __forceinline__ unsigned cvt_pk_bf16(float lo, float hi) { typedef __bf16 bf2 __attribute__((ext_vector_type(2))); f32x2 v = {lo, hi}; bf2 b = __builtin_convertvector(v, bf2); return __builtin_bit_cast(unsigned, b); }

struct EpiGemm1 {
    static constexpr bool PERM = true;
    bf16_t* UV; float* vsq;
    __device__ __forceinline__ void operator()(const f32x4 (&acc)[2][2][4][2], const pg8::Unit& u, int wr, int wc, int fr, int fq) const {
        const int row0 = u.pm * 256 + wr * 64 + fr, col0 = u.pn * 256 + wc * 32 + 8 * fq; const bool isv = u.pn >= 8;
#pragma unroll
        for (int ai = 0; ai < 2; ++ai)
#pragma unroll
            for (int m = 0; m < 4; ++m) { const int row = row0 + ai * 128 + m * 16; bf16_t* rowp = UV + (size_t)row * 4096 + col0; float ss = 0.f;
#pragma unroll
                for (int bj = 0; bj < 2; ++bj) { const f32x4 v0 = acc[ai][bj][m][0], v1 = acc[ai][bj][m][1];
                    const float g0 = gelu_tanh(v0[0]), g1 = gelu_tanh(v0[1]), g2 = gelu_tanh(v0[2]), g3 = gelu_tanh(v0[3]), g4 = gelu_tanh(v1[0]), g5 = gelu_tanh(v1[1]), g6 = gelu_tanh(v1[2]), g7 = gelu_tanh(v1[3]);
                    ss += (g0 * g0 + g1 * g1) + (g2 * g2 + g3 * g3) + (g4 * g4 + g5 * g5) + (g6 * g6 + g7 * g7);
                    u32x4 w; w.x = cvt_pk_bf16(g0, g1); w.y = cvt_pk_bf16(g2, g3); w.z = cvt_pk_bf16(g4, g5); w.w = cvt_pk_bf16(g6, g7);
                    *(u32x4*)(rowp + bj * 128) = w; }
                if (isv) { ss += __shfl_xor(ss, 16); ss += __shfl_xor(ss, 32); if (fq == 0) vsq[(size_t)row * 32 + (u.pn - 8) * 4 + wc] = ss; } }
    }
};
struct EpiGemm1Q {
    static constexpr bool PERM = true;
    bf16_t* UV; float* vsq; const float* hs; const unsigned* amax;
    __device__ __forceinline__ void operator()(const f32x4 (&acc)[2][2][4][2], const pg8::Unit& u, int wr, int wc, int fr, int fq) const {
        const int row0 = u.pm * 256 + wr * 64 + fr, col0 = u.pn * 256 + wc * 32 + 8 * fq; const bool isv = u.pn >= 8;
        f32x4 cs[2][2];
#pragma unroll
        for (int bj = 0; bj < 2; ++bj)
#pragma unroll
            for (int n = 0; n < 2; ++n) { const u32x4 a = *(const u32x4*)(amax + col0 + bj * 128 + 4 * n);
                cs[bj][n] = (f32x4){__uint_as_float(a.x), __uint_as_float(a.y), __uint_as_float(a.z), __uint_as_float(a.w)} * (1.f / 127.f); }
        float rscv[2][4];
#pragma unroll
        for (int ai = 0; ai < 2; ++ai)
#pragma unroll
            for (int m = 0; m < 4; ++m) rscv[ai][m] = hs[row0 + ai * 128 + m * 16];
        asm volatile("" : "+v"(rscv[0][0]), "+v"(rscv[0][1]), "+v"(rscv[0][2]), "+v"(rscv[0][3]), "+v"(rscv[1][0]), "+v"(rscv[1][1]), "+v"(rscv[1][2]), "+v"(rscv[1][3]));
#pragma unroll
        for (int ai = 0; ai < 2; ++ai)
#pragma unroll
            for (int m = 0; m < 4; ++m) { const int row = row0 + ai * 128 + m * 16; bf16_t* rowp = UV + (size_t)row * 4096 + col0; f32x2 ss2 = (f32x2){0.f, 0.f}; const float rsc = rscv[ai][m];
#pragma unroll
                for (int bj = 0; bj < 2; ++bj) { const pg8::v4i32 i0 = __builtin_bit_cast(pg8::v4i32, acc[ai][bj][m][0]), i1 = __builtin_bit_cast(pg8::v4i32, acc[ai][bj][m][1]);
                    const f32x4 v0 = (f32x4){(float)i0[0], (float)i0[1], (float)i0[2], (float)i0[3]} * cs[bj][0] * rsc, v1 = (f32x4){(float)i1[0], (float)i1[1], (float)i1[2], (float)i1[3]} * cs[bj][1] * rsc;
                    const f32x2 ga = gelu_tanh2((f32x2){v0[0], v0[1]}), gb = gelu_tanh2((f32x2){v0[2], v0[3]}), gc = gelu_tanh2((f32x2){v1[0], v1[1]}), gd = gelu_tanh2((f32x2){v1[2], v1[3]});
                    ss2 = ga * ga + ss2; ss2 = gb * gb + ss2; ss2 = gc * gc + ss2; ss2 = gd * gd + ss2;
                    u32x4 w; w.x = cvt_pk_bf16(ga.x, ga.y); w.y = cvt_pk_bf16(gb.x, gb.y); w.z = cvt_pk_bf16(gc.x, gc.y); w.w = cvt_pk_bf16(gd.x, gd.y);
                    *(u32x4*)(rowp + bj * 128) = w; }
                if (isv) { float ss = ss2.x + ss2.y; ss += __shfl_xor(ss, 16); ss += __shfl_xor(ss, 32); if (fq == 0) vsq[(size_t)row * 32 + (u.pn - 8) * 4 + wc] = ss; } }
    }
};
struct EpiGateUpQ {
    static constexpr bool PERM = true;
    bf16_t* HID; const float* hs; const unsigned* amax; const LAS int* idxtab; const unsigned char* ws;
    __device__ __forceinline__ void operator()(const f32x4 (&acc)[2][2][4][2], const pg8::Unit& u, int wr, int wc, int fr, int fq) const {
        const int row0 = u.pm * 256 + wr * 64 + fr, col0 = u.pn * 128 + wc * 32 + 8 * fq;
        const unsigned* ap = amax + u.e * 1024 + u.pn * 256 + wc * 32 + 8 * fq;
        f32x4 cs[2][2];
#pragma unroll
        for (int bj = 0; bj < 2; ++bj)
#pragma unroll
            for (int n = 0; n < 2; ++n) { const u32x4 a = *(const u32x4*)(ap + bj * 128 + 4 * n);
                cs[bj][n] = (f32x4){__uint_as_float(a.x), __uint_as_float(a.y), __uint_as_float(a.z), __uint_as_float(a.w)} * (1.f / 127.f); }
        const LAS int* tab = idxtab + u.sel * 256 + wr * 64 + fr;
        float rscv[2][4];
#pragma unroll
        for (int ai = 0; ai < 2; ++ai)
#pragma unroll
            for (int m = 0; m < 4; ++m) rscv[ai][m] = hs[tab[ai * 128 + m * 16]];
        asm volatile("" : "+v"(rscv[0][0]), "+v"(rscv[0][1]), "+v"(rscv[0][2]), "+v"(rscv[0][3]), "+v"(rscv[1][0]), "+v"(rscv[1][1]), "+v"(rscv[1][2]), "+v"(rscv[1][3]));
#pragma unroll
        for (int ai = 0; ai < 2; ++ai)
#pragma unroll
            for (int m = 0; m < 4; ++m) { const float rsc = rscv[ai][m];
                const pg8::v4i32 ig0 = __builtin_bit_cast(pg8::v4i32, acc[ai][0][m][0]), ig1 = __builtin_bit_cast(pg8::v4i32, acc[ai][0][m][1]), iu0 = __builtin_bit_cast(pg8::v4i32, acc[ai][1][m][0]), iu1 = __builtin_bit_cast(pg8::v4i32, acc[ai][1][m][1]);
                const f32x4 g0 = (f32x4){(float)ig0[0], (float)ig0[1], (float)ig0[2], (float)ig0[3]} * cs[0][0] * rsc, g1 = (f32x4){(float)ig1[0], (float)ig1[1], (float)ig1[2], (float)ig1[3]} * cs[0][1] * rsc;
                const f32x4 u0 = (f32x4){(float)iu0[0], (float)iu0[1], (float)iu0[2], (float)iu0[3]} * cs[1][0] * rsc, u1 = (f32x4){(float)iu1[0], (float)iu1[1], (float)iu1[2], (float)iu1[3]} * cs[1][1] * rsc;
                u32x4 w;
                w.x = cvt_pk_bf16(silu_f(g0[0]) * u0[0], silu_f(g0[1]) * u0[1]); w.y = cvt_pk_bf16(silu_f(g0[2]) * u0[2], silu_f(g0[3]) * u0[3]);
                w.z = cvt_pk_bf16(silu_f(g1[0]) * u1[0], silu_f(g1[1]) * u1[1]); w.w = cvt_pk_bf16(silu_f(g1[2]) * u1[2], silu_f(g1[3]) * u1[3]);
                st16_wt(ws, HID + (size_t)(row0 + ai * 128 + m * 16) * DE + col0, w); }
    }
};
struct EpiQkvQ {
    static constexpr bool PERM = false;
    bf16_t *Q, *K, *V; const float* hs; const unsigned* amax;
    __device__ __forceinline__ void operator()(const f32x4 (&acc)[2][2][4][2], const pg8::Unit& u, int wr, int wc, int fr, int fq) const {
        const int row0 = u.pm * 256 + wr * 64 + fr; const bool rope = (u.pn < 5) && (u.pm < 64);
        bf16_t* base; int ld, colt; float sc = 1.f;
        if (u.pn < 4) { base = Q; ld = 1024; colt = u.pn * 256; sc = QSCALE; } else if (u.pn == 4) { base = K; ld = KVD; colt = 0; } else { base = V; ld = KVD; colt = 0; }
        const int col0 = colt + wc * 32 + 4 * fq; const unsigned* ap = amax + u.pn * 256 + wc * 32 + 4 * fq;
        f32x4 cs[2][2];
#pragma unroll
        for (int bj = 0; bj < 2; ++bj)
#pragma unroll
            for (int n = 0; n < 2; ++n) { const u32x4 a = *(const u32x4*)(ap + bj * 128 + 16 * n);
                cs[bj][n] = (f32x4){__uint_as_float(a.x), __uint_as_float(a.y), __uint_as_float(a.z), __uint_as_float(a.w)} * (1.f / 127.f); }
        float rscv[2][4];
#pragma unroll
        for (int ai = 0; ai < 2; ++ai)
#pragma unroll
            for (int m = 0; m < 4; ++m) rscv[ai][m] = hs[row0 + ai * 128 + m * 16];
        asm volatile("" : "+v"(rscv[0][0]), "+v"(rscv[0][1]), "+v"(rscv[0][2]), "+v"(rscv[0][3]), "+v"(rscv[1][0]), "+v"(rscv[1][1]), "+v"(rscv[1][2]), "+v"(rscv[1][3]));
        float inv[4];
#pragma unroll
        for (int i = 0; i < 4; ++i) inv[i] = exp2f(-(float)(4 * fq + i) * (13.287712379549449f / 16.f)) * 0.15915494309189535f;
#pragma unroll
        for (int ai = 0; ai < 2; ++ai)
#pragma unroll
            for (int m = 0; m < 4; ++m) { const int row = row0 + ai * 128 + m * 16; const int pos = row & 2047; const float pp = (float)((wc & 1) ? (pos & 63) : (pos >> 6));
                const float rsc = rscv[ai][m];
                float cs_[4], sn[4];
#pragma unroll
                for (int i = 0; i < 4; ++i) { float rev = pp * inv[i]; rev -= floorf(rev); sn[i] = rope ? __builtin_amdgcn_sinf(rev) : 0.f; cs_[i] = rope ? __builtin_amdgcn_cosf(rev) : 1.f; }
#pragma unroll
                for (int bj = 0; bj < 2; ++bj) { const pg8::v4i32 i1 = __builtin_bit_cast(pg8::v4i32, acc[ai][bj][m][0]), i2 = __builtin_bit_cast(pg8::v4i32, acc[ai][bj][m][1]);
                    const f32x4 x1 = (f32x4){(float)i1[0], (float)i1[1], (float)i1[2], (float)i1[3]} * cs[bj][0] * rsc, x2 = (f32x4){(float)i2[0], (float)i2[1], (float)i2[2], (float)i2[3]} * cs[bj][1] * rsc;
                    float o1[4], o2[4];
#pragma unroll
                    for (int i = 0; i < 4; ++i) { o1[i] = (x1[i] * cs_[i] - x2[i] * sn[i]) * sc; o2[i] = (x2[i] * cs_[i] + x1[i] * sn[i]) * sc; }
                    bf16_t* p = base + (size_t)row * ld + col0 + bj * 128;
                    u32x2 w1, w2; w1.x = cvt_pk_bf16(o1[0], o1[1]); w1.y = cvt_pk_bf16(o1[2], o1[3]); w2.x = cvt_pk_bf16(o2[0], o2[1]); w2.y = cvt_pk_bf16(o2[2], o2[3]);
                    *(u32x2*)p = w1; *(u32x2*)(p + 16) = w2; } }
    }
};
struct EpiGemm2 {
    static constexpr bool PERM = true;
    const float* x0; const float* c0; bf16_t* xbh; const float* modf;
    __device__ __forceinline__ void operator()(const f32x4 (&acc)[2][2][4][2], const pg8::Unit& u, int wr, int wc, int fr, int fq) const {
        const int rowt = u.pm * 256; const bool isx = rowt < NX;
        const float* src = isx ? x0 + (size_t)rowt * D : c0 + (size_t)(rowt - NX) * D; bf16_t* dst = xbh + (size_t)rowt * D;
        const float* g1p = modf + (size_t)(rowt / 2048) * 6144 + 2048;
        const int col0 = u.pn * 256 + wc * 32 + 8 * fq;
        f32x4 g1[2][2];
#pragma unroll
        for (int bj = 0; bj < 2; ++bj)
#pragma unroll
            for (int n = 0; n < 2; ++n) g1[bj][n] = *(const f32x4*)(g1p + col0 + bj * 128 + n * 4);
#pragma unroll
        for (int ai = 0; ai < 2; ++ai)
#pragma unroll
            for (int m = 0; m < 4; ++m) { const size_t off = (size_t)(ai * 128 + wr * 64 + m * 16 + fr) * D + col0;
#pragma unroll
                for (int bj = 0; bj < 2; ++bj) { const f32x4 xa = *(const f32x4*)(src + off + bj * 128), xb = *(const f32x4*)(src + off + bj * 128 + 4);
                    const f32x4 ya = xa + g1[bj][0] * acc[ai][bj][m][0], yb = xb + g1[bj][1] * acc[ai][bj][m][1]; u32x4 w;
                    w.x = cvt_pk_bf16(ya[0], ya[1]); w.y = cvt_pk_bf16(ya[2], ya[3]); w.z = cvt_pk_bf16(yb[0], yb[1]); w.w = cvt_pk_bf16(yb[2], yb[3]);
                    *(u32x4*)(dst + off + bj * 128) = w; } }
    }
};
struct EpiWo {
    static constexpr bool PERM = true;
    bf16_t* xbh; const float* modf1;
    __device__ __forceinline__ void operator()(const f32x4 (&acc)[2][2][4][2], const pg8::Unit& u, int wr, int wc, int fr, int fq) const {
        const int rowt = u.pm * 256; bf16_t* dst = xbh + (size_t)rowt * D; const float* g1p = modf1 + (size_t)(rowt / 2048) * 6144 + 2048;
        const int col0 = u.pn * 256 + wc * 32 + 8 * fq;
        f32x4 g1[2][2];
#pragma unroll
        for (int bj = 0; bj < 2; ++bj)
#pragma unroll
            for (int n = 0; n < 2; ++n) g1[bj][n] = *(const f32x4*)(g1p + col0 + bj * 128 + n * 4);
#pragma unroll
        for (int ai = 0; ai < 2; ++ai)
#pragma unroll
            for (int m = 0; m < 4; ++m) { const size_t off = (size_t)(ai * 128 + wr * 64 + m * 16 + fr) * D + col0;
#pragma unroll
                for (int bj = 0; bj < 2; ++bj) { bf16_t* p = dst + off + bj * 128; const u32x4 xw = *(const u32x4*)p;
                    const f32x4 xa = (f32x4){__uint_as_float(xw.x << 16), __uint_as_float(xw.x & 0xffff0000u), __uint_as_float(xw.y << 16), __uint_as_float(xw.y & 0xffff0000u)};
                    const f32x4 xb = (f32x4){__uint_as_float(xw.z << 16), __uint_as_float(xw.z & 0xffff0000u), __uint_as_float(xw.w << 16), __uint_as_float(xw.w & 0xffff0000u)};
                    const f32x4 ya = xa + g1[bj][0] * acc[ai][bj][m][0], yb = xb + g1[bj][1] * acc[ai][bj][m][1]; u32x4 w;
                    w.x = cvt_pk_bf16(ya[0], ya[1]); w.y = cvt_pk_bf16(ya[2], ya[3]); w.z = cvt_pk_bf16(yb[0], yb[1]); w.w = cvt_pk_bf16(yb[2], yb[3]);
                    *(u32x4*)p = w; } }
    }
};
struct EpiGateUp {
    static constexpr bool PERM = true;
    bf16_t* HID;
    __device__ __forceinline__ void operator()(const f32x4 (&acc)[2][2][4][2], const pg8::Unit& u, int wr, int wc, int fr, int fq) const {
        const int row0 = u.pm * 256 + wr * 64 + fr, col0 = u.pn * 128 + wc * 32 + 8 * fq;
#pragma unroll
        for (int ai = 0; ai < 2; ++ai)
#pragma unroll
            for (int m = 0; m < 4; ++m) { const f32x4 g0 = acc[ai][0][m][0], g1 = acc[ai][0][m][1], u0 = acc[ai][1][m][0], u1 = acc[ai][1][m][1]; u32x4 w;
                w.x = cvt_pk_bf16(silu_f(g0[0]) * u0[0], silu_f(g0[1]) * u0[1]); w.y = cvt_pk_bf16(silu_f(g0[2]) * u0[2], silu_f(g0[3]) * u0[3]);
                w.z = cvt_pk_bf16(silu_f(g1[0]) * u1[0], silu_f(g1[1]) * u1[1]); w.w = cvt_pk_bf16(silu_f(g1[2]) * u1[2], silu_f(g1[3]) * u1[3]);
                *(u32x4*)(HID + (size_t)(row0 + ai * 128 + m * 16) * DE + col0) = w; }
    }
};
struct EpiDown {
    static constexpr bool PERM = true;
    bf16_t* Y;
    __device__ __forceinline__ void operator()(const f32x4 (&acc)[2][2][4][2], const pg8::Unit& u, int wr, int wc, int fr, int fq) const {
        const int row0 = u.pm * 256 + wr * 64 + fr, col0 = u.pn * 256 + wc * 32 + 8 * fq;
#pragma unroll
        for (int ai = 0; ai < 2; ++ai)
#pragma unroll
            for (int m = 0; m < 4; ++m) { bf16_t* rowp = Y + (size_t)(row0 + ai * 128 + m * 16) * D + col0;
#pragma unroll
                for (int bj = 0; bj < 2; ++bj) { const f32x4 v0 = acc[ai][bj][m][0], v1 = acc[ai][bj][m][1]; u32x4 w;
                    w.x = cvt_pk_bf16(v0[0], v0[1]); w.y = cvt_pk_bf16(v0[2], v0[3]); w.z = cvt_pk_bf16(v1[0], v1[1]); w.w = cvt_pk_bf16(v1[2], v1[3]);
                    *(u32x4*)(rowp + bj * 128) = w; } }
    }
};
struct EpiQkv {
    static constexpr bool PERM = false;
    bf16_t *Q, *K, *V;
    __device__ __forceinline__ void operator()(const f32x4 (&acc)[2][2][4][2], const pg8::Unit& u, int wr, int wc, int fr, int fq) const {
        const int row0 = u.pm * 256 + wr * 64 + fr; const bool rope = (u.pn < 5) && (u.pm < 64);
        bf16_t* base; int ld, colt; float sc = 1.f;
        if (u.pn < 4) { base = Q; ld = 1024; colt = u.pn * 256; sc = QSCALE; } else if (u.pn == 4) { base = K; ld = KVD; colt = 0; } else { base = V; ld = KVD; colt = 0; }
        const int col0 = colt + wc * 32 + 4 * fq;
        float inv[4];
#pragma unroll
        for (int i = 0; i < 4; ++i) inv[i] = exp2f(-(float)(4 * fq + i) * (13.287712379549449f / 16.f)) * 0.15915494309189535f;
#pragma unroll
        for (int ai = 0; ai < 2; ++ai)
#pragma unroll
            for (int m = 0; m < 4; ++m) { const int row = row0 + ai * 128 + m * 16; const int pos = row & 2047; const float pp = (float)((wc & 1) ? (pos & 63) : (pos >> 6));
                float cs[4], sn[4];
#pragma unroll
                for (int i = 0; i < 4; ++i) { float rev = pp * inv[i]; rev -= floorf(rev); sn[i] = rope ? __builtin_amdgcn_sinf(rev) : 0.f; cs[i] = rope ? __builtin_amdgcn_cosf(rev) : 1.f; }
#pragma unroll
                for (int bj = 0; bj < 2; ++bj) { const f32x4 x1 = acc[ai][bj][m][0], x2 = acc[ai][bj][m][1]; float o1[4], o2[4];
#pragma unroll
                    for (int i = 0; i < 4; ++i) { o1[i] = (x1[i] * cs[i] - x2[i] * sn[i]) * sc; o2[i] = (x2[i] * cs[i] + x1[i] * sn[i]) * sc; }
                    bf16_t* p = base + (size_t)row * ld + col0 + bj * 128;
                    u32x2 w1, w2; w1.x = cvt_pk_bf16(o1[0], o1[1]); w1.y = cvt_pk_bf16(o1[2], o1[3]); w2.x = cvt_pk_bf16(o2[0], o2[1]); w2.y = cvt_pk_bf16(o2[2], o2[3]);
                    *(u32x2*)p = w1; *(u32x2*)(p + 16) = w2; } }
    }
};

struct CtxSplitOrder {
    static constexpr bool WAITS = false, SIGNALS = false;
    int c;
    __device__ bool next(int i, pg8::Unit& u) const { if (i > 0 || c >= 64) return false; const int tile = c >> 1; u.pm = 64 + (tile >> 2); u.pn = tile & 3; u.e = 0; u.aux = c & 1; u.lbase = 0; u.koff = (c & 1) * 2048; return true; }
    __device__ const int* idx_ptr(const pg8::Unit&, int) const { return nullptr; }
};
struct EpiCtxPartial {
    static constexpr bool PERM = true;
    bf16_t* cxp;
    __device__ __forceinline__ void operator()(const f32x4 (&acc)[2][2][4][2], const pg8::Unit& u, int wr, int wc, int fr, int fq) const {
        bf16_t* dst = cxp + (size_t)u.aux * NCX * D + (size_t)(u.pm * 256 - NX) * D; const int col0 = u.pn * 256 + wc * 32 + 8 * fq;
#pragma unroll
        for (int ai = 0; ai < 2; ++ai)
#pragma unroll
            for (int m = 0; m < 4; ++m) { const size_t off = (size_t)(ai * 128 + wr * 64 + m * 16 + fr) * D + col0;
#pragma unroll
                for (int bj = 0; bj < 2; ++bj) { const f32x4 v0 = acc[ai][bj][m][0], v1 = acc[ai][bj][m][1]; u32x4 w;
                    w.x = cvt_pk_bf16(v0[0], v0[1]); w.y = cvt_pk_bf16(v0[2], v0[3]); w.z = cvt_pk_bf16(v1[0], v1[1]); w.w = cvt_pk_bf16(v1[2], v1[3]);
                    *(u32x4*)(dst + off + bj * 128) = w; } }
    }
};
__device__ __forceinline__ void phase_gemm1_fast(Frame& F) {
    pg8::Gemm g{F.hq(), F.winq(), D, D, D, 0}; pg8::StaticOrder S; S.init(NT, 4096, F.G, (int)blockIdx.x);
    EpiGemm1Q E{F.u(), F.vsq(), F.hs(), F.amax_in()};
    pg8::gemm_phase<EpiGemm1Q, pg8::StaticOrder, false, false, true, true>(F.lds, g, S, E, nullptr);
}
__device__ __forceinline__ void phase_gemm2_fast(Frame& F) {
    if (F.G == 256) {
        { pg8::Gemm g{F.u(), F.wout(), 2 * U_LD, 2 * AW, 2 * AW, 0}; pg8::StaticOrder S; S.init(NX, D, F.G, (int)blockIdx.x);
          EpiGemm2 E{F.in[I_X], F.in[I_CTX], F.xbh(), F.modf()};
          pg8::gemm_phase<EpiGemm2, pg8::StaticOrder, false, false, true>(F.lds, g, S, E, nullptr); }
        { pg8::Gemm g{F.u(), F.wout(), 2 * U_LD, 2 * AW, AW, 0}; CtxSplitOrder S{(int)blockIdx.x};
          EpiCtxPartial E{F.cxp()};
          pg8::gemm_phase<EpiCtxPartial, CtxSplitOrder, false, false, true>(F.lds, g, S, E, nullptr); }
        return; }
    pg8::Gemm g{F.u(), F.wout(), 2 * U_LD, 2 * AW, 2 * AW, 0}; pg8::StaticOrder S; S.init(NT, D, F.G, (int)blockIdx.x);
    EpiGemm2 E{F.in[I_X], F.in[I_CTX], F.xbh(), F.modf()};
    pg8::gemm_phase<EpiGemm2, pg8::StaticOrder, false, false, true>(F.lds, g, S, E, nullptr);
}
__device__ __forceinline__ void phase_wo_fast(Frame& F) {
    pg8::Gemm g{F.o(), F.wo(), 2 * D, 2 * D, 2 * D, 0}; pg8::StaticOrderW S; S.init(NX, D, F.G, (int)blockIdx.x); S.rdy = F.ctl() + CW_RDYO; S.tmo = F.ctl() + CW_BAR + XB_TMO; S.need = 64u;
    EpiWo E{F.xbh(), F.modf() + (size_t)9 * 6144};
    pg8::gemm_phase<EpiWo, pg8::StaticOrderW, false, false, true>(F.lds, g, S, E, nullptr);
}
__device__ __forceinline__ void phase_qkv_fast(Frame& F) {
    pg8::Gemm g{F.hq(), F.wqkvq(), D, D, D, 0}; pg8::QkvOrder S{F.G, (int)blockIdx.x};
    EpiQkvQ E{F.q(), F.k(), F.v(), F.hs(), F.amax_qkv()};
    pg8::gemm_phase<EpiQkvQ, pg8::QkvOrder, false, false, true, true>(F.lds, g, S, E, nullptr);
}
__device__ __forceinline__ LAS int* moe_table(Frame& F, int l) {
    LAS int* tab = (LAS int*)(F.lds + LDSCTL_OFF + 1024);
    const unsigned* cnt = F.ctl() + CW_CNT + 16 * l;
    __syncthreads();
    if (F.tid == 0) { int t = 0; for (int e = 0; e < 16; ++e) { const int n = (int)cnt[e]; tab[e] = t; tab[17 + e] = n; t += (n + 255) >> 8; } tab[16] = t; }
    __syncthreads();
    return tab;
}
__device__ __forceinline__ void phase_moe_gu(Frame& F, int l, int seg) {
    LAS int* tab = moe_table(F, l);
    LAS int* idxtab = (LAS int*)(F.lds + LDSCTL_OFF + 2048);
    pg8::Gemm g{F.hq(), F.guq() + (size_t)l * 16 * 1024 * 1024, D, D, D, (size_t)1024 * 1024};
    pg8::MoeOrderT<1> S{tab, F.list(), F.G, (int)blockIdx.x, F.ctl() + CW_RDY + l * 160 * 64, F.ctl() + CW_BAR + XB_TMO};
    EpiGateUpQ E{F.hid(), F.hs(), F.amax_gu() + l * 16 * 1024, idxtab, F.ws};
    pg8::gemm_phase<EpiGateUpQ, pg8::MoeOrderT<1>, true, false, true, true>(F.lds, g, S, E, idxtab);
    if (seg >= 0) filler_static(F, seg, (tab[16] * 4) % F.G, 0);
}
__device__ __forceinline__ void phase_moe_dn(Frame& F, int l, int seg) {
    LAS int* tab = moe_table(F, l);
    const int rem = (tab[16] * 4) % F.G; int rot = (rem + 7) & ~7; if (rot >= F.G) rot = 0;
    const int cr = ((int)blockIdx.x - rot + F.G) % F.G;
    pg8::Gemm g{F.hid(), F.dn() + (size_t)l * 16 * 1024 * 512, 2 * DE, 2 * DE, 2 * DE, (size_t)2 * 1024 * 512};
    pg8::MoeOrderT<2> S{tab, F.list(), F.G, cr, F.ctl() + CW_RDY + l * 160 * 64, F.ctl() + CW_BAR + XB_TMO};
    EpiDown E{F.y()};
    pg8::gemm_phase<EpiDown, pg8::MoeOrderT<2>, false, false, true>(F.lds, g, S, E, nullptr);
    if (seg >= 0) filler_static(F, seg, rem, rot);
}

typedef short s16x4 __attribute__((ext_vector_type(4)));
__device__ __forceinline__ void phase_sgu_fast(Frame& F) {
    constexpr int SA = 136, SB = 264;
    LAS bf16_t* As = (LAS bf16_t*)F.lds; LAS bf16_t* Bs = As + 128 * SA; LAS float* rs = (LAS float*)(Bs + 128 * SB);
    const int tid = F.tid, lane = F.lane, wave = F.wave, wr = wave >> 2, wc = wave & 3, fr = lane & 15, fq = lane >> 4;
    const int nb = F.G >> 3, g = blockIdx.x & 7; int c = blockIdx.x >> 3;
    if ((int)blockIdx.x >= nb * 8 || c >= 144) return;
    __syncthreads();
#pragma unroll
    for (int i = 0; i < 4; ++i) { const int idx = tid + 512 * i, r = idx >> 4, ck = idx & 15;
        *(LAS u32x4*)(As + r * SA + ck * 8) = *(const u32x4*)(F.wsbf() + (size_t)g * 16384 + r * 128 + ck * 8); }
    const int vr0 = tid >> 5, vck = tid & 31;
    const f32x4 ga = *(const f32x4*)(F.in[I_AGV] + g * 256 + vck * 8), gb = *(const f32x4*)(F.in[I_AGV] + g * 256 + vck * 8 + 4);
    float bsv[4];
#pragma unroll
    for (int m = 0; m < 4; ++m) bsv[m] = F.in[I_ABS][g * 128 + wr * 64 + m * 16 + fr];
    auto rstd_of = [&](int cc, int t) { const float* p = F.vsq() + (size_t)(cc * 128 + t) * 32; float s = 0.f;
#pragma unroll
        for (int j = 0; j < 32; j += 4) { const f32x4 q = *(const f32x4*)(p + j); s += (q.x + q.y) + (q.z + q.w); }
        return rsqrtf(s * (1.f / AW) + EPS); };
    if (tid < 128) rs[tid] = rstd_of(c, tid);
    u32x4 vreg[8];
    { const bf16_t* vb = F.u() + (size_t)c * 128 * 4096 + 2048 + g * 256 + vck * 8;
#pragma unroll
      for (int i = 0; i < 8; ++i) vreg[i] = *(const u32x4*)(vb + (size_t)(vr0 + 16 * i) * 4096); }
    __syncthreads();
    int cur = 0;
    for (; c < 144; c += nb) {
        const int cn = c + nb; const bool has_next = cn < 144;
#pragma unroll
        for (int i = 0; i < 8; ++i) { const int r = vr0 + 16 * i; const u32x4 w = vreg[i]; const float sc = rs[cur * 128 + r]; u32x4 o;
            o.x = cvt_pk_bf16(__uint_as_float(w.x << 16) * sc * ga.x, __uint_as_float(w.x & 0xffff0000u) * sc * ga.y);
            o.y = cvt_pk_bf16(__uint_as_float(w.y << 16) * sc * ga.z, __uint_as_float(w.y & 0xffff0000u) * sc * ga.w);
            o.z = cvt_pk_bf16(__uint_as_float(w.z << 16) * sc * gb.x, __uint_as_float(w.z & 0xffff0000u) * sc * gb.y);
            o.w = cvt_pk_bf16(__uint_as_float(w.w << 16) * sc * gb.z, __uint_as_float(w.w & 0xffff0000u) * sc * gb.w);
            *(LAS u32x4*)(Bs + r * SB + vck * 8) = o; }
        bf16_t* ub = F.u() + (size_t)c * 128 * 4096 + g * 256 + vck * 8;
        u32x4 ureg[8];
#pragma unroll
        for (int i = 0; i < 8; ++i) ureg[i] = *(const u32x4*)(ub + (size_t)(vr0 + 16 * i) * 4096);
        if (has_next) { const bf16_t* vb = F.u() + (size_t)cn * 128 * 4096 + 2048 + g * 256 + vck * 8;
#pragma unroll
            for (int i = 0; i < 8; ++i) vreg[i] = *(const u32x4*)(vb + (size_t)(vr0 + 16 * i) * 4096);
            if (tid < 128) rs[(cur ^ 1) * 128 + tid] = rstd_of(cn, tid); }
        __syncthreads();
        f32x4 acc[4][4];
#pragma unroll
        for (int m = 0; m < 4; ++m)
#pragma unroll
            for (int n = 0; n < 4; ++n) acc[m][n] = (f32x4){0.f, 0.f, 0.f, 0.f};
#pragma unroll
        for (int ks = 0; ks < 4; ++ks) {
            bf16x8 bw[4], av[4];
#pragma unroll
            for (int m = 0; m < 4; ++m) bw[m] = *(const LAS bf16x8*)(As + (wr * 64 + m * 16 + fr) * SA + ks * 32 + fq * 8);
#pragma unroll
            for (int n = 0; n < 4; ++n) { const LAS bf16_t* p = Bs + (ks * 32 + fq * 8 + (fr >> 2)) * SB + wc * 64 + n * 16 + 4 * (fr & 3);
                const s16x4 lo = __builtin_bit_cast(s16x4, __builtin_amdgcn_ds_read_tr16_b64_v4i16((LAS s16x4*)p));
                const s16x4 hi = __builtin_bit_cast(s16x4, __builtin_amdgcn_ds_read_tr16_b64_v4i16((LAS s16x4*)(p + 4 * SB)));
                av[n] = (bf16x8){lo[0], lo[1], lo[2], lo[3], hi[0], hi[1], hi[2], hi[3]}; }
#pragma unroll
            for (int m = 0; m < 4; ++m)
#pragma unroll
                for (int n = 0; n < 4; ++n) acc[m][n] = __builtin_amdgcn_mfma_f32_16x16x32_bf16(av[n], bw[m], acc[m][n], 0, 0, 0);
        }
        __syncthreads();
#pragma unroll
        for (int m = 0; m < 4; ++m)
#pragma unroll
            for (int n = 0; n < 4; ++n) { const f32x4 a = acc[m][n]; u32x2 o; o.x = cvt_pk_bf16(a[0] + bsv[m], a[1] + bsv[m]); o.y = cvt_pk_bf16(a[2] + bsv[m], a[3] + bsv[m]);
                *(LAS u32x2*)(Bs + (wr * 64 + m * 16 + fr) * SB + wc * 64 + n * 16 + 4 * fq) = o; }
        __syncthreads();
#pragma unroll
        for (int i = 0; i < 8; ++i) { const int r = vr0 + 16 * i; const u32x4 z = *(const LAS u32x4*)(Bs + r * SB + vck * 8); const u32x4 w = ureg[i]; u32x4 o;
            o.x = cvt_pk_bf16(__uint_as_float(w.x << 16) * __uint_as_float(z.x << 16), __uint_as_float(w.x & 0xffff0000u) * __uint_as_float(z.x & 0xffff0000u));
            o.y = cvt_pk_bf16(__uint_as_float(w.y << 16) * __uint_as_float(z.y << 16), __uint_as_float(w.y & 0xffff0000u) * __uint_as_float(z.y & 0xffff0000u));
            o.z = cvt_pk_bf16(__uint_as_float(w.z << 16) * __uint_as_float(z.z << 16), __uint_as_float(w.z & 0xffff0000u) * __uint_as_float(z.z & 0xffff0000u));
            o.w = cvt_pk_bf16(__uint_as_float(w.w << 16) * __uint_as_float(z.w << 16), __uint_as_float(w.w & 0xffff0000u) * __uint_as_float(z.w & 0xffff0000u));
            *(u32x4*)(ub + (size_t)r * 4096) = o; }
        __syncthreads();
        cur ^= 1;
    }
}

namespace att {
typedef float f32x16 __attribute__((ext_vector_type(16)));
constexpr int SLOTB = 8192, LDS_K = 0, LDS_V = 3 * SLOTB, LDS_WS = 7 * SLOTB, LDS_OST = LDS_WS + 8 * 512, LDS_TOTAL = LDS_OST + 8 * 4096;
__device__ __forceinline__ int crow(int r, int hi) { return (r & 3) + 8 * (r >> 2) + 4 * hi; }
#define ATT_WAIT_BAR(N) asm volatile("s_waitcnt vmcnt(" #N ") lgkmcnt(0)\n\ts_barrier" ::: "memory")
#define ATT_BAR() asm volatile("s_waitcnt lgkmcnt(0)\n\ts_barrier" ::: "memory")
__device__ __forceinline__ void glds16(const void* gsrc, unsigned lds_dst) { unsigned keep;
    asm volatile("s_mov_b32 %0, m0\n\ts_mov_b32 m0, %2\n\ts_nop 0\n\tglobal_load_lds_dwordx4 %1, off\n\ts_mov_b32 m0, %0" : "=&s"(keep) : "v"(gsrc), "s"(lds_dst) : "memory"); }
__device__ __forceinline__ s16x4 vtr(const LAS char* p) { return __builtin_bit_cast(s16x4, __builtin_amdgcn_ds_read_tr16_b64_v4i16((LAS s16x4*)p)); }

template <int MODE> __device__ __forceinline__ void attn_unit(Frame& F, int b, int hk, int qblk, int prev_pm) {
    const int lane = F.lane, wave = F.wave, r32 = lane & 31, hi = lane >> 5;
    const int grp = wave >> 2, wq = wave & 3;
    const int half = grp;
    const int head = hk * 4 + wq, s = qblk * 128;
    LAS char* lds = (LAS char*)F.lds;
    LAS float* wsf = (LAS float*)(lds + LDS_WS) + wave * 128;
    const unsigned lds0 = (unsigned)(size_t)lds;
    const bf16_t* Qw = F.q() + (size_t)(b * SEQ + s + half * 64) * 1024 + head * 64;
    bf16x8 qr[2][4];
#pragma unroll
    for (int sb = 0; sb < 2; ++sb)
#pragma unroll
        for (int d0 = 0; d0 < 4; ++d0) qr[sb][d0] = *(const bf16x8*)(Qw + (size_t)(sb * 32 + r32) * 1024 + d0 * 16 + hi * 8);
    const int t_lo = (2 - 2 * qblk) > 0 ? (2 - 2 * qblk) : 0, t_hi = (33 - 2 * qblk) < 5 ? (33 - 2 * qblk) : 5, ntl = 4 + (t_hi - t_lo + 1);
    const bf16_t* Kc = F.k() + (size_t)(NX + b * CTXL) * KVD + hk * 64; const bf16_t* Vc = F.v() + (size_t)(NX + b * CTXL) * KVD + hk * 64;
    const bf16_t* Kx = F.k() + (size_t)(b * SEQ) * KVD + hk * 64; const bf16_t* Vx = F.v() + (size_t)(b * SEQ) * KVD + hk * 64;
    const int koff = lane * KVD + wave * 8;
    const int voff = (16 * (wave & 3) + (lane >> 2)) * KVD + (wave >> 2) * 32 + (lane & 3) * 8;
#define ATT_DMA(i) do { const int ii = (i); const bf16_t *kp, *vp; \
        if (ii < 4) { kp = Kc + (size_t)ii * 64 * KVD; vp = Vc + (size_t)ii * 64 * KVD; } else { const int kpos0 = s - 128 + 64 * (t_lo + ii - 4); kp = Kx + (size_t)kpos0 * KVD; vp = Vx + (size_t)kpos0 * KVD; } \
        glds16(kp + koff, (unsigned)__builtin_amdgcn_readfirstlane(lds0 + LDS_K + (ii % 3) * SLOTB + wave * 1024)); \
        glds16(vp + voff, (unsigned)__builtin_amdgcn_readfirstlane(lds0 + LDS_V + (ii & 3) * SLOTB + wave * 1024)); } while (0)
    asm volatile("s_waitcnt vmcnt(0)" ::: "memory");
    if (prev_pm >= 0 && lane == 0) (void)__hip_atomic_fetch_add(F.ctl() + CW_RDYO + 64 * prev_pm, 1u, __ATOMIC_RELAXED, __HIP_MEMORY_SCOPE_AGENT);
    ATT_DMA(0); ATT_DMA(1);
    const float m0 = F.in[I_BSINK][head] * LOG2E;
    float m[2] = {m0, m0}, l[2] = {hi == 0 ? 1.f : 0.f, hi == 0 ? 1.f : 0.f};
    f32x16 o[2][2];
#pragma unroll
    for (int sb = 0; sb < 2; ++sb)
#pragma unroll
        for (int r = 0; r < 16; ++r) { o[sb][0][r] = 0.f; o[sb][1][r] = 0.f; }
    f32x16 p0[2], p1[2]; bf16x8 pa[2][4]; bool resc[2] = {false, false};
#pragma unroll
    for (int sb = 0; sb < 2; ++sb) {
#pragma unroll
        for (int r = 0; r < 16; ++r) { p0[sb][r] = 0.f; p1[sb][r] = 0.f; }
#pragma unroll
        for (int ks = 0; ks < 4; ++ks) pa[sb][ks] = (bf16x8){0, 0, 0, 0, 0, 0, 0, 0}; }
    ATT_WAIT_BAR(2);
    if (grp) { ATT_BAR(); __builtin_amdgcn_s_setprio(1); }
    bool act_prev = false;
    for (int j = 0; j <= ntl; ++j) {
        const int t = j < 4 ? -1 : t_lo + j - 4;
        const bool act = (j < ntl) && (t != 5 * (1 - half));
        const bool issue = j + 2 < ntl;
        if (issue) ATT_DMA(j + 2);
        if (act && MODE != 2) {
            const LAS char* kb = lds + LDS_K + (j % 3) * SLOTB + hi * 1024 + r32 * 16;
#pragma unroll
            for (int sb = 0; sb < 2; ++sb) { const float nm = -m[sb];
#pragma unroll
                for (int r = 0; r < 16; ++r) { p0[sb][r] = nm; p1[sb][r] = nm; } }
#pragma unroll
            for (int d0 = 0; d0 < 4; ++d0) { const bf16x8 b0 = *(const LAS bf16x8*)(kb + d0 * 2048), b1 = *(const LAS bf16x8*)(kb + d0 * 2048 + 512);
#pragma unroll
                for (int sb = 0; sb < 2; ++sb) { p0[sb] = __builtin_amdgcn_mfma_f32_32x32x16_bf16(b0, qr[sb][d0], p0[sb], 0, 0, 0); p1[sb] = __builtin_amdgcn_mfma_f32_32x32x16_bf16(b1, qr[sb][d0], p1[sb], 0, 0, 0); } }
        }
        if (act_prev && MODE != 2) {
            const LAS char* vp = lds + LDS_V + ((j - 1) & 3) * SLOTB + ((lane >> 4) & 1) * 32 + (lane & 3) * 8 + (4 * hi + ((lane & 15) >> 2)) * 64;
#pragma unroll
            for (int d0 = 0; d0 < 2; ++d0)
#pragma unroll
                for (int ks = 0; ks < 4; ++ks) { const s16x4 lo = vtr(vp + d0 * 4096 + ks * 1024), hh = vtr(vp + d0 * 4096 + ks * 1024 + 512);
                    const bf16x8 vf = (bf16x8){lo[0], lo[1], lo[2], lo[3], hh[0], hh[1], hh[2], hh[3]};
#pragma unroll
                    for (int sb = 0; sb < 2; ++sb) o[sb][d0] = __builtin_amdgcn_mfma_f32_32x32x16_bf16(pa[sb][ks], vf, o[sb][d0], 0, 0, 0); }
        }
        if (issue) { ATT_WAIT_BAR(2); } else { ATT_WAIT_BAR(0); }
        if (act && MODE != 1) {
#pragma unroll
            for (int sb = 0; sb < 2; ++sb) {
                const int qo = sb * 32 + r32;
                if (t == half) {
#pragma unroll
                    for (int r = 0; r < 16; ++r) { const int kv = crow(r, hi); if (kv < qo) p0[sb][r] = -INFINITY; if (kv + 32 < qo) p1[sb][r] = -INFINITY; }
                } else if (t == 4 + half) {
#pragma unroll
                    for (int r = 0; r < 16; ++r) { const int kv = crow(r, hi); if (kv > qo) p0[sb][r] = -INFINITY; if (kv + 32 > qo) p1[sb][r] = -INFINITY; }
                }
#define ATT_MX3(a, b, c) __builtin_fmaxf(__builtin_fmaxf((a), (b)), (c))
                float ra = ATT_MX3(p0[sb][0], p0[sb][1], p1[sb][0]), rb = ATT_MX3(p0[sb][2], p0[sb][3], p1[sb][1]); ra = ATT_MX3(ra, p1[sb][2], p1[sb][3]);
#pragma unroll
                for (int r = 4; r < 16; r += 4) { ra = ATT_MX3(ra, p0[sb][r], p0[sb][r + 1]); rb = ATT_MX3(rb, p0[sb][r + 2], p0[sb][r + 3]); ra = ATT_MX3(ra, p1[sb][r], p1[sb][r + 1]); rb = ATT_MX3(rb, p1[sb][r + 2], p1[sb][r + 3]); }
#undef ATT_MX3
                float rm = __builtin_fmaxf(ra, rb);
                rm = __builtin_fmaxf(rm, __shfl_xor(rm, 32));
                resc[sb] = __any(rm > 8.f) != 0;
                if (resc[sb]) { const float dl = __builtin_fmaxf(rm, 0.f); m[sb] += dl;
#pragma unroll
                    for (int r = 0; r < 16; ++r) { p0[sb][r] -= dl; p1[sb][r] -= dl; }
                    const float f = __builtin_amdgcn_exp2f(-dl); l[sb] *= f; if (hi == 0) wsf[sb * 32 + r32] = f; }
                f32x2 rs2 = (f32x2){0.f, 0.f};
#pragma unroll
                for (int r = 0; r < 16; r += 2) { p0[sb][r] = __builtin_amdgcn_exp2f(p0[sb][r]); p0[sb][r + 1] = __builtin_amdgcn_exp2f(p0[sb][r + 1]); p1[sb][r] = __builtin_amdgcn_exp2f(p1[sb][r]); p1[sb][r + 1] = __builtin_amdgcn_exp2f(p1[sb][r + 1]);
                    rs2 += (f32x2){p0[sb][r], p0[sb][r + 1]}; rs2 += (f32x2){p1[sb][r], p1[sb][r + 1]}; }
                l[sb] += rs2.x + rs2.y;
                u32x4 w;
                w.x = cvt_pk_bf16(p0[sb][0], p0[sb][1]); w.y = cvt_pk_bf16(p0[sb][2], p0[sb][3]); w.z = cvt_pk_bf16(p0[sb][4], p0[sb][5]); w.w = cvt_pk_bf16(p0[sb][6], p0[sb][7]); pa[sb][0] = __builtin_bit_cast(bf16x8, w);
                w.x = cvt_pk_bf16(p0[sb][8], p0[sb][9]); w.y = cvt_pk_bf16(p0[sb][10], p0[sb][11]); w.z = cvt_pk_bf16(p0[sb][12], p0[sb][13]); w.w = cvt_pk_bf16(p0[sb][14], p0[sb][15]); pa[sb][1] = __builtin_bit_cast(bf16x8, w);
                w.x = cvt_pk_bf16(p1[sb][0], p1[sb][1]); w.y = cvt_pk_bf16(p1[sb][2], p1[sb][3]); w.z = cvt_pk_bf16(p1[sb][4], p1[sb][5]); w.w = cvt_pk_bf16(p1[sb][6], p1[sb][7]); pa[sb][2] = __builtin_bit_cast(bf16x8, w);
                w.x = cvt_pk_bf16(p1[sb][8], p1[sb][9]); w.y = cvt_pk_bf16(p1[sb][10], p1[sb][11]); w.z = cvt_pk_bf16(p1[sb][12], p1[sb][13]); w.w = cvt_pk_bf16(p1[sb][14], p1[sb][15]); pa[sb][3] = __builtin_bit_cast(bf16x8, w);
            }
#pragma unroll
            for (int sb = 0; sb < 2; ++sb)
                if (resc[sb]) {
#pragma unroll
                    for (int r = 0; r < 16; ++r) { const float fr_ = wsf[sb * 32 + crow(r, hi)]; o[sb][0][r] *= fr_; o[sb][1][r] *= fr_; } }
        }
        act_prev = act;
        ATT_BAR();
    }
    if (!grp) ATT_BAR(); else __builtin_amdgcn_s_setprio(0);
    LAS bf16_t* stg = (LAS bf16_t*)(lds + LDS_OST) + wave * 2048;
#pragma unroll
    for (int sb = 0; sb < 2; ++sb) {
        float ls = l[sb]; ls += __shfl_xor(ls, 32);
        if (hi == 0) wsf[64 + sb * 32 + r32] = ls;
        float rli[16];
#pragma unroll
        for (int r = 0; r < 16; ++r) rli[r] = __builtin_amdgcn_rcpf(wsf[64 + sb * 32 + crow(r, hi)]);
#pragma unroll
        for (int r = 0; r < 16; ++r) { const int orow = crow(r, hi);
#pragma unroll
            for (int d0 = 0; d0 < 2; ++d0) stg[orow * 64 + d0 * 32 + r32] = (bf16_t)f2bf(o[sb][d0][r] * rli[r]); }
        bf16_t* Ow = F.o() + (size_t)(b * SEQ + s + half * 64 + sb * 32) * 1024 + head * 64;
#pragma unroll
        for (int i = 0; i < 4; ++i) { const int row = i * 8 + (lane >> 3), ch = lane & 7; const u32x4 v = *(const LAS u32x4*)(stg + row * 64 + ch * 8); st16_wt(F.ws, Ow + (size_t)row * 1024 + ch * 8, v); }
    }
#undef ATT_DMA
}
#undef ATT_WAIT_BAR
#undef ATT_BAR
}
__device__ __forceinline__ void phase_attn_fast(Frame& F) {
    int prev_pm = -1;
    for (int u = blockIdx.x; u < NBATCH * 4 * 16; u += F.G) { att::attn_unit<0>(F, u >> 6, (u >> 4) & 3, u & 15, prev_pm); prev_pm = (u >> 6) * 8 + ((u & 15) >> 1); }
    asm volatile("s_waitcnt vmcnt(0)" ::: "memory");
    if (prev_pm >= 0 && F.lane == 0) (void)__hip_atomic_fetch_add(F.ctl() + CW_RDYO + 64 * prev_pm, 1u, __ATOMIC_RELAXED, __HIP_MEMORY_SCOPE_AGENT);
}
template <int MODE> __device__ __forceinline__ void phase_attn_probe(Frame& F) {
    for (int u = blockIdx.x; u < NBATCH * 4 * 16; u += F.G) att::attn_unit<MODE>(F, u >> 6, (u >> 4) & 3, u & 15, -1);
}


struct EpiPlain4096 {
    static constexpr bool PERM = true;
    bf16_t* O;
    __device__ __forceinline__ void operator()(const f32x4 (&acc)[2][2][4][2], const pg8::Unit& u, int wr, int wc, int fr, int fq) const {
        const int row0 = u.pm * 256 + wr * 64 + fr, col0 = u.pn * 256 + wc * 32 + 8 * fq;
#pragma unroll
        for (int ai = 0; ai < 2; ++ai)
#pragma unroll
            for (int m = 0; m < 4; ++m) { bf16_t* rowp = O + (size_t)(row0 + ai * 128 + m * 16) * 4096 + col0;
#pragma unroll
                for (int bj = 0; bj < 2; ++bj) { const f32x4 v0 = acc[ai][bj][m][0], v1 = acc[ai][bj][m][1]; u32x4 w;
                    w.x = cvt_pk_bf16(v0[0], v0[1]); w.y = cvt_pk_bf16(v0[2], v0[3]); w.z = cvt_pk_bf16(v1[0], v1[1]); w.w = cvt_pk_bf16(v1[2], v1[3]);
                    *(u32x4*)(rowp + bj * 128) = w; } }
    }
};
__device__ __forceinline__ void phase_gemm1_plain(Frame& F) {
    pg8::Gemm g{F.h(), F.win(), 2 * D, 2 * D, 2 * D, 0}; pg8::StaticOrder S; S.init(NT, 4096, F.G, (int)blockIdx.x);
    EpiPlain4096 E{F.u()};
    pg8::gemm_phase<EpiPlain4096, pg8::StaticOrder, false, false, true>(F.lds, g, S, E, nullptr);
}
__device__ __forceinline__ int moe_first_idle(Frame& F, int l) { const unsigned* cnt = F.ctl() + CW_CNT + 16 * l; int t = 0; for (int e = 0; e < 16; ++e) t += ((int)cnt[e] + 255) >> 8; return (4 * t) % F.G; }
constexpr int N_PHASES = 19;
__global__ void __launch_bounds__(NTHREADS, 2) fwd_kernel(Params args) {
    extern __shared__ __attribute__((aligned(16))) unsigned char lds_raw[];
    Frame F;
    F.in = args.in; F.out = args.out; F.ws = args.ws; F.lds = (LAS unsigned char*)lds_raw;
    F.tid = threadIdx.x; F.lane = F.tid & 63; F.wave = __builtin_amdgcn_readfirstlane(F.tid >> 6); F.G = gridDim.x;
    for (int u = F.tid; u < (LDS_BYTES - LDSCTL_OFF) / 4; u += NTHREADS) ((LAS unsigned*)(F.lds + LDSCTL_OFF))[u] = 0u;
    __syncthreads();
    XcdBarrier bar; bar.bar = F.ctl() + CW_BAR; bar.x = 0; bar.st = nullptr;
    if (MK_N_LAUNCHES == 1) bar = xcd_barrier_post(F.ctl() + CW_BAR, (volatile LAS unsigned*)(F.lds + MISC_OFF) + 8);
    const int lo = args.ph_lo, hi = args.ph_hi;
#define IN(k) (lo <= (k) && (k) < hi)
#define SEAM(k) do { if (IN(k) && IN((k) + 1)) xcd_barrier(bar); } while (0)
#ifndef PROBE_PHASE
#define PROBE_PHASE -1
#endif
#ifndef PROBE_REPS
#define PROBE_REPS 1
#endif
#define REP(k) for (int _rep = 0; _rep < ((k) == PROBE_PHASE ? PROBE_REPS : 1); ++_rep, ((k) == PROBE_PHASE && _rep < PROBE_REPS ? xcd_barrier(bar) : (void)0))
    if (IN(0)) REP(0) { phase_prologue(F); } SEAM(0);
    if (IN(1)) REP(1) { phase_norm1_l0(F); } SEAM(1);
    if (IN(2)) REP(2) { if (FAST_MIX) phase_gemm1_fast(F); else phase_gemm1_naive(F); filler_static(F, 0, (72 * 16) % F.G); } SEAM(2);
    if (!FAST_MIX) { if (IN(3)) { phase_vsq_naive(F); } SEAM(3); }
    if (!FAST_MIX) { if (IN(4)) { phase_vnorm_naive(F); } SEAM(4); }
    if (IN(5)) REP(5) { if (FAST_MIX) phase_sgu_fast(F); else phase_sgu_naive(F); } SEAM(5);
    if (IN(6)) REP(6) { if (FAST_G2) phase_gemm2_fast(F); else phase_gemm2_naive(F); filler_static(F, 1, F.G == 256 ? 64 : (72 * 4) % F.G); } SEAM(6);
    if (IN(7)) REP(7) { phase_norm2_route(F, 0, NT); } SEAM(7);
    if (IN(8)) REP(8) { phase_moe_gu(F, 0, 2); }
    if (IN(9)) REP(9) { phase_moe_dn(F, 0, 3); }
    if (IN(9) && IN(10)) xcd_barrier(bar, CombinePro{&F, 0, NT, false});
    if (IN(10)) REP(10) { phase_combine<false>(F, 0, NT, IN(9)); } SEAM(10);
    if (IN(11)) REP(11) { if (FAST_QKV) phase_qkv_fast(F); else phase_qkv_naive(F); filler_static(F, 4, 400 % F.G); } SEAM(11);
    if (!FAST_QKV) { if (IN(12)) { phase_rope_naive(F); } SEAM(12); }
    if (IN(13)) REP(13) { if (FAST_ATTN) phase_attn_fast(F); else phase_attn_naive(F); }
    if (IN(14)) REP(14) { if (FAST_WO) phase_wo_fast(F); else phase_wo_naive(F); } SEAM(14);
    if (IN(15)) REP(15) { phase_norm2_route(F, 1, NX); } SEAM(15);
    if (IN(16)) REP(16) { phase_moe_gu(F, 1, -1); }
    if (IN(17)) REP(17) { phase_moe_dn(F, 1, -1); }
    if (IN(17) && IN(18)) xcd_barrier(bar, CombinePro{&F, 1, NX, true});
    if (IN(18)) REP(18) { phase_combine<true>(F, 1, NX, IN(17)); }
#ifndef PROBE_TAIL
#define PROBE_TAIL 0
#endif
    if (PROBE_TAIL != 0) {
        xcd_barrier(bar);
        Frame F2 = F; F2.out = (float*)(args.ws + WS_OV + 80 * MiB);
        if (PROBE_TAIL == 7) { phase_norm2_route(F, 0, NT); xcd_barrier(bar); phase_norm2_route(F, 0, NT); xcd_barrier(bar); }
        if (PROBE_TAIL == 10) { phase_combine<false>(F2, 0, NT); xcd_barrier(bar); phase_combine<false>(F2, 0, NT); xcd_barrier(bar); }
        if (PROBE_TAIL == 14) { phase_wo_fast(F2); xcd_barrier(bar); phase_wo_fast(F2); xcd_barrier(bar); }
        if (PROBE_TAIL == 1) { phase_norm1_l0(F); xcd_barrier(bar); phase_norm1_l0(F); xcd_barrier(bar); }
        if (PROBE_TAIL == 2) { phase_gemm1_fast(F); xcd_barrier(bar); phase_gemm1_fast(F); xcd_barrier(bar); }
        if (PROBE_TAIL == 22) { phase_gemm1_plain(F); xcd_barrier(bar); phase_gemm1_plain(F); xcd_barrier(bar); }
        if (PROBE_TAIL == 130) { phase_attn_probe<0>(F); xcd_barrier(bar); phase_attn_probe<0>(F); xcd_barrier(bar); }
        if (PROBE_TAIL == 131) { phase_attn_probe<1>(F); xcd_barrier(bar); phase_attn_probe<1>(F); xcd_barrier(bar); }
        if (PROBE_TAIL == 132) { phase_attn_probe<2>(F); xcd_barrier(bar); phase_attn_probe<2>(F); xcd_barrier(bar); }
        if (PROBE_TAIL == 50) { phase_prologue(F); xcd_barrier(bar); phase_prologue(F); xcd_barrier(bar); }
        if (PROBE_TAIL == 5) { phase_sgu_fast(F); xcd_barrier(bar); phase_sgu_fast(F); xcd_barrier(bar); }
        if (PROBE_TAIL == 6) { phase_gemm2_fast(F); xcd_barrier(bar); phase_gemm2_fast(F); xcd_barrier(bar); }
        if (PROBE_TAIL == 11) { phase_qkv_fast(F); xcd_barrier(bar); phase_qkv_fast(F); xcd_barrier(bar); }
        if (PROBE_TAIL == 71) { phase_norm2_route_t<1>(F, 0, NT); xcd_barrier(bar); phase_norm2_route_t<1>(F, 0, NT); xcd_barrier(bar); }
        if (PROBE_TAIL == 72) { phase_norm2_route_t<2>(F, 0, NT); xcd_barrier(bar); phase_norm2_route_t<2>(F, 0, NT); xcd_barrier(bar); }
        if (PROBE_TAIL == 73) { phase_norm2_route_t<3>(F, 0, NT); xcd_barrier(bar); phase_norm2_route_t<3>(F, 0, NT); xcd_barrier(bar); }
        if (PROBE_TAIL == 100) { for (int i = 0; i < 20; ++i) xcd_barrier(bar); }
    }
#undef IN
#undef SEAM
}
__global__ void zero_out_kernel(float* out, int n) { for (int i = blockIdx.x * blockDim.x + threadIdx.x; i < n; i += gridDim.x * blockDim.x) out[i] = 0.f; }

extern "C" void kernel_launch(void* const* d_in, const int* in_sizes, int n_in, void* d_out, int out_size, void* d_ws, size_t ws_size, hipStream_t stream) {
    static int grid = 0;
    if (grid == 0) {
        int dev = 0, cus = 0, per_cu = 0;
        (void)hipGetDevice(&dev); (void)hipDeviceGetAttribute(&cus, hipDeviceAttributeMultiprocessorCount, dev);
        if (hipFuncSetAttribute((const void*)fwd_kernel, hipFuncAttributeMaxDynamicSharedMemorySize, LDS_BYTES) != hipSuccess) { fprintf(stderr, "kernel_launch: hipFuncSetAttribute failed\n"); }
        (void)hipOccupancyMaxActiveBlocksPerMultiprocessor(&per_cu, (const void*)fwd_kernel, NTHREADS, LDS_BYTES);
        (void)hipGetLastError();
        if (per_cu < 1) per_cu = 1;
        grid = cus > 0 ? cus : 256;
        fprintf(stderr, "kernel_launch: cus %d per_cu %d grid %d ws %zu need %zu\n", cus, per_cu, grid, ws_size, (size_t)WS_END);
    }
    if (n_in != 22 || ws_size < WS_END || out_size != NX * D) {
        zero_out_kernel<<<256, 256, 0, stream>>>((float*)d_out, out_size);
        return;
    }
    (void)hipMemsetAsync((char*)d_ws + WS_CTL, 0, CTL_ZERO_BYTES, stream);
    Params a{};
    for (int i = 0; i < 22; ++i) a.in[i] = (const float*)d_in[i];
    a.out = (float*)d_out; a.ws = (unsigned char*)d_ws;
    if (MK_N_LAUNCHES == 1) {
        a.ph_lo = 0; a.ph_hi = N_PHASES;
        void* kargs[] = {&a};
        (void)hipLaunchCooperativeKernel((const void*)fwd_kernel, dim3(grid), dim3(NTHREADS), kargs, LDS_BYTES, stream);
    } else {
        for (int ph = 0; ph < N_PHASES; ++ph) { a.ph_lo = ph; a.ph_hi = ph + 1; hipLaunchKernelGGL(fwd_kernel, dim3(grid), dim3(NTHREADS), LDS_BYTES, stream, a); }
    }
}
```
